# Optimizing an MI355X kernel written in HIP

```python
import functools
import jax, jax.numpy as jnp
from jax import lax
import numpy as np


D_MODEL = 1024
BATCH = 16
SEQ = 256
DEPTH = 4
DEC_BATCH = 8
DEC_SEQ = 4096
PAST_LEN = 256

GRID_W = 64
N_ATT_HEADS = 8
HEAD_DIM = 64
ATT_WIDTH = N_ATT_HEADS * HEAD_DIM
ATT_SCALE = HEAD_DIM ** -0.5
WIN_ROWS = 8
WIN_COLS = 16
LRU_WIDTH = D_MODEL // 2
LRU_BLOCKS = 8
LRU_BLOCK = LRU_WIDTH // LRU_BLOCKS
CONV_W = 4
CONV_LEFT = 2
LRU_C = 8.0
MIX_WIDTH = ATT_WIDTH + LRU_WIDTH
IN_COLS = 3 * ATT_WIDTH + 2 * LRU_WIDTH
D_FF = -(-8 * D_MODEL // (3 * 256)) * 256
EPS = 1e-6
NEG_INF = -1e30

kernel_name = 'hybrid_natten_rglru_diffusion_step'


def rmsnorm(x, g):
    xf = x.astype(jnp.float32)
    y = xf * lax.rsqrt(jnp.mean(xf * xf, axis=-1, keepdims=True) + EPS)
    return (y * g.astype(jnp.float32)).astype(x.dtype)


def adaln(cvec, w_mod, b_mod):
    m = jax.nn.silu(cvec) @ w_mod + b_mod
    return [t[:, None, :] for t in jnp.split(m, 6, axis=-1)]


def split_heads(t):
    return t.reshape(t.shape[0], t.shape[1], N_ATT_HEADS, HEAD_DIM)


def context_attention(q, k, v):
    s = jnp.einsum('bqhd,bkhd->bhqk', q, k).astype(jnp.float32) * ATT_SCALE
    p = jax.nn.softmax(s, axis=-1).astype(v.dtype)
    o = jnp.einsum('bhqk,bkhd->bqhd', p, v)
    return o.reshape(o.shape[0], o.shape[1], ATT_WIDTH)


def latent_attention(q, k, v, k_ctx, v_ctx, rpb):
    bsz, t_len = q.shape[0], q.shape[1]
    rows = t_len // GRID_W
    kh = min(WIN_ROWS, rows)
    n_loc = kh * GRID_W
    qg = q.reshape(bsz, rows, GRID_W, N_ATT_HEADS, HEAD_DIM)
    kg = k.reshape(bsz, rows, GRID_W, N_ATT_HEADS, HEAD_DIM)
    vg = v.reshape(bsz, rows, GRID_W, N_ATT_HEADS, HEAD_DIM)
    col = jnp.arange(GRID_W)
    cs = jnp.clip(col - WIN_COLS // 2, 0, GRID_W - WIN_COLS)
    col_ok = (col[None, :] >= cs[:, None]) & (col[None, :] < cs[:, None] + WIN_COLS)
    col_idx = jnp.clip(col[None, :] - col[:, None] + WIN_COLS - 1, 0, 2 * WIN_COLS - 2)
    key_ok = jnp.tile(col_ok, (1, kh))

    def row_block(r):
        rs = jnp.clip(r - kh // 2, 0, rows - kh)
        kb = lax.dynamic_slice_in_dim(kg, rs, kh, axis=1).reshape(bsz, n_loc, N_ATT_HEADS, HEAD_DIM)
        vb = lax.dynamic_slice_in_dim(vg, rs, kh, axis=1).reshape(bsz, n_loc, N_ATT_HEADS, HEAD_DIM)
        qr = lax.dynamic_index_in_dim(qg, r, axis=1, keepdims=False)
        row_idx = rs + jnp.arange(kh) - r + WIN_ROWS - 1
        bias = rpb[:, row_idx[:, None, None], col_idx[None, :, :]]
        bias = bias.transpose(0, 2, 1, 3).reshape(N_ATT_HEADS, GRID_W, n_loc).astype(jnp.float32)
        s_loc = jnp.einsum('bqhd,bkhd->bhqk', qr, kb).astype(jnp.float32) * ATT_SCALE + bias
        s_loc = jnp.where(key_ok, s_loc, NEG_INF)
        s_ctx = jnp.einsum('bqhd,bkhd->bhqk', qr, k_ctx).astype(jnp.float32) * ATT_SCALE
        p = jax.nn.softmax(jnp.concatenate([s_loc, s_ctx], axis=-1), axis=-1).astype(v.dtype)
        return (jnp.einsum('bhqk,bkhd->bqhd', p[..., :n_loc], vb)
                + jnp.einsum('bhqk,bkhd->bqhd', p[..., n_loc:], v_ctx))

    o = lax.map(row_block, jnp.arange(rows))
    return o.transpose(1, 0, 2, 3, 4).reshape(bsz, t_len, ATT_WIDTH)


def centred_conv(x, w, b):
    t_len = x.shape[1]
    xp = jnp.pad(x, ((0, 0), (CONV_LEFT, CONV_W - 1 - CONV_LEFT), (0, 0)))
    y = b
    for j in range(CONV_W):
        y = y + w[j] * xp[:, j:j + t_len]
    return y


def block_diag(x, w, b):
    xb = x.reshape(x.shape[0], x.shape[1], LRU_BLOCKS, LRU_BLOCK)
    return jnp.einsum('btnj,njk->btnk', xb, w).reshape(x.shape) + b


def _lru_combine(e1, e2):
    a1, b1 = e1
    a2, b2 = e2
    return a1 * a2, a2 * b1 + b2


def rg_lru(xc, a_param, w_r, b_r, w_i, b_i, h0, reverse):
    r = jax.nn.sigmoid(block_diag(xc, w_r, b_r).astype(jnp.float32))
    i = jax.nn.sigmoid(block_diag(xc, w_i, b_i).astype(jnp.float32))
    log_a = LRU_C * r * jax.nn.log_sigmoid(a_param.astype(jnp.float32))
    a = jnp.exp(log_a)
    bx = jnp.sqrt(-jnp.expm1(2.0 * log_a)) * i * xc.astype(jnp.float32)
    edge = -1 if reverse else 0
    bx = bx.at[:, edge].add(a[:, edge] * h0.astype(jnp.float32))
    _, h = lax.associative_scan(_lru_combine, (a, bx), reverse=reverse, axis=1)
    return h


def lru_branch(xb, yb, conv_w, conv_b, lru_a, lru_wr, lru_br, lru_wi, lru_bi, h0):
    xc = centred_conv(xb, conv_w, conv_b)
    hf = rg_lru(xc, lru_a[0], lru_wr[0], lru_br[0], lru_wi[0], lru_bi[0], h0[:, 0], False)
    hb = rg_lru(xc, lru_a[1], lru_wr[1], lru_br[1], lru_wi[1], lru_bi[1], h0[:, 1], True)
    out = (hf + hb).astype(yb.dtype) * jax.nn.gelu(yb)
    final = jnp.stack([hf[:, -1], hb[:, 0]], axis=1)
    return out, final


def trunk_layer(x, mod, attend, h0, norm1, norm2, w_in, w_out, conv_w, conv_b,
                lru_a, lru_wr, lru_br, lru_wi, lru_bi, w_gate, w_up, w_down):
    sh1, sc1, g1, sh2, sc2, g2 = mod
    h = rmsnorm(x, norm1) * (1 + sc1) + sh1
    p = h @ w_in
    q = split_heads(p[..., :ATT_WIDTH])
    k = split_heads(p[..., ATT_WIDTH:2 * ATT_WIDTH])
    v = split_heads(p[..., 2 * ATT_WIDTH:3 * ATT_WIDTH])
    xb = p[..., 3 * ATT_WIDTH:3 * ATT_WIDTH + LRU_WIDTH]
    yb = p[..., 3 * ATT_WIDTH + LRU_WIDTH:]
    att = attend(q, k, v)
    rec, h_final = lru_branch(xb, yb, conv_w, conv_b, lru_a, lru_wr, lru_br, lru_wi, lru_bi, h0)
    x = x + g1 * (jnp.concatenate([att, rec], axis=-1) @ w_out)
    h2 = rmsnorm(x, norm2) * (1 + sc2) + sh2
    x = x + g2 * ((jax.nn.silu(h2 @ w_gate) * (h2 @ w_up)) @ w_down)
    return x, k, v, h_final


def setup_inputs(seed: int = 0) -> dict:
    key = jax.random.key(seed)
    ks = jax.random.split(key, 32)

    def nrm(k, shape, scale):
        return jax.random.normal(k, shape, jnp.float32) * scale

    u = jax.random.uniform(ks[16], (DEPTH, 2, LRU_WIDTH), jnp.float32, 0.9, 0.999)
    return {
        'x_prompt': nrm(ks[0], (BATCH, SEQ, D_MODEL), 1.0),
        'x_sample': nrm(ks[1], (DEC_BATCH, DEC_SEQ, D_MODEL), 1.0),
        'cache_k': nrm(ks[2], (DEC_BATCH, DEPTH, PAST_LEN, N_ATT_HEADS, HEAD_DIM), 1.0),
        'cache_v': nrm(ks[3], (DEC_BATCH, DEPTH, PAST_LEN, N_ATT_HEADS, HEAD_DIM), 1.0),
        'state_lru': nrm(ks[4], (DEC_BATCH, DEPTH, 2, LRU_WIDTH), 0.5),
        'c': nrm(ks[5], (DEC_BATCH, D_MODEL), 1.0),
        'c_ctx': nrm(ks[6], (D_MODEL,), 1.0),
        'w_mod': nrm(ks[7], (DEPTH, D_MODEL, 6 * D_MODEL), 0.5 * D_MODEL ** -0.5),
        'b_mod': nrm(ks[8], (DEPTH, 6 * D_MODEL), 0.02),
        'norm1': 1.0 + nrm(ks[9], (DEPTH, D_MODEL), 0.02),
        'norm2': 1.0 + nrm(ks[10], (DEPTH, D_MODEL), 0.02),
        'w_in': nrm(ks[11], (DEPTH, D_MODEL, IN_COLS), D_MODEL ** -0.5),
        'w_out': nrm(ks[12], (DEPTH, MIX_WIDTH, D_MODEL), MIX_WIDTH ** -0.5),
        'rpb': nrm(ks[13], (DEPTH, N_ATT_HEADS, 2 * WIN_ROWS - 1, 2 * WIN_COLS - 1), 0.1),
        'conv_w': nrm(ks[14], (DEPTH, CONV_W, LRU_WIDTH), CONV_W ** -0.5),
        'conv_b': nrm(ks[15], (DEPTH, LRU_WIDTH), 0.02),
        'lru_a': jnp.log(u) - jnp.log1p(-u),
        'lru_wr': nrm(ks[17], (DEPTH, 2, LRU_BLOCKS, LRU_BLOCK, LRU_BLOCK), LRU_BLOCK ** -0.5),
        'lru_br': nrm(ks[18], (DEPTH, 2, LRU_WIDTH), 0.02),
        'lru_wi': nrm(ks[19], (DEPTH, 2, LRU_BLOCKS, LRU_BLOCK, LRU_BLOCK), LRU_BLOCK ** -0.5),
        'lru_bi': nrm(ks[20], (DEPTH, 2, LRU_WIDTH), 0.02),
        'w_gate': nrm(ks[21], (DEPTH, D_MODEL, D_FF), D_MODEL ** -0.5),
        'w_up': nrm(ks[22], (DEPTH, D_MODEL, D_FF), D_MODEL ** -0.5),
        'w_down': nrm(ks[23], (DEPTH, D_FF, D_MODEL), D_FF ** -0.5),
        'norm_final': 1.0 + nrm(ks[24], (D_MODEL,), 0.02),
    }


def reference(x_prompt, x_sample, cache_k, cache_v, state_lru, c, c_ctx, w_mod, b_mod, norm1, norm2,
              w_in, w_out, rpb, conv_w, conv_b, lru_a, lru_wr, lru_br, lru_wi, lru_bi,
              w_gate, w_up, w_down, norm_final):
    xp, xs = x_prompt, x_sample
    h0_ctx = jnp.zeros((x_prompt.shape[0], 2, LRU_WIDTH), jnp.float32)
    ks_out, vs_out, hs_out = [], [], []
    for l in range(DEPTH):
        weights = (norm1[l], norm2[l], w_in[l], w_out[l], conv_w[l], conv_b[l], lru_a[l], lru_wr[l],
                   lru_br[l], lru_wi[l], lru_bi[l], w_gate[l], w_up[l], w_down[l])
        mod_ctx = adaln(c_ctx[None, :], w_mod[l], b_mod[l])
        xp, k_l, v_l, h_l = trunk_layer(xp, mod_ctx, context_attention, h0_ctx, *weights)
        ks_out.append(k_l)
        vs_out.append(v_l)
        hs_out.append(h_l)
        mod_lat = adaln(c, w_mod[l], b_mod[l])
        attend_lat = functools.partial(latent_attention, k_ctx=cache_k[:, l], v_ctx=cache_v[:, l], rpb=rpb[l])
        xs, _, _, _ = trunk_layer(xs, mod_lat, attend_lat, state_lru[:, l], *weights)
    y_prompt = rmsnorm(xp, norm_final)
    y_sample = rmsnorm(xs, norm_final)
    new_cache_k = jnp.stack(ks_out, axis=1)
    new_cache_v = jnp.stack(vs_out, axis=1)
    new_state_lru = jnp.stack(hs_out, axis=1)
    return (y_prompt, y_sample, new_cache_k, new_cache_v, new_state_lru)
```

```cpp
#include <hip/hip_runtime.h>
#include <hip/hip_cooperative_groups.h>
#include <cstdio>
#include <cstdint>
namespace cg = cooperative_groups;

constexpr int DM = 1024, NCTX = 4096, NLAT = 32768, MTOK = 36864, DEPTH = 4, NIN = 2560, DFF = 2816, NGU = 5632;
constexpr int OUT_K = MTOK * DM, OUT_V = OUT_K + 16 * 4 * 256 * 512, OUT_ST = OUT_V + 16 * 4 * 256 * 512;
constexpr size_t MiB = 1u << 20;
constexpr size_t WS_MODS = 1 * MiB, WS_LRUW = 2 * MiB, WS_AGG = 3 * MiB, WS_CK = 8 * MiB, WS_CVT = 16 * MiB, WS_WIN = 24 * MiB, WS_WOUT = 44 * MiB,
                 WS_WGU = 52 * MiB, WS_WDN = 96 * MiB, WS_HN = 120 * MiB, WS_Q = 192 * MiB, WS_K = 228 * MiB, WS_VT = 264 * MiB, WS_XB = 300 * MiB,
                 WS_YB = 336 * MiB, WS_MIX = 372 * MiB, WS_ACT = 192 * MiB, WS_CARRY = 444 * MiB, WS_PART = 448 * MiB, WS_BIAS1 = 452 * MiB, WS_BIAS2 = 453 * MiB, WS_WP = 455 * MiB;
namespace pg8 {
#define PG8_LAS __attribute__((address_space(3)))
typedef unsigned short bf16_t;
typedef short bf16x8 __attribute__((ext_vector_type(8)));
typedef float f32x4 __attribute__((ext_vector_type(4)));
typedef unsigned u32x4 __attribute__((ext_vector_type(4)));
constexpr int BM = 256, BK = 64, HALF = 128, HTB = HALF * BK * 2  , STAGE_BYTES = 8 * HTB, NXCD = 8, WGM = 4;

__host__ __device__ __forceinline__ int lds_byte(int r, int c) { const int st = (r >> 4) * 2 + (c >> 5), rr = r & 15, cc = c & 31, ob = rr * 64 + cc * 2; return st * 1024 + (ob ^ (((ob >> 9) & 1) << 5)); }
__host__ __device__ __forceinline__ void stage_rc(int b, int& R, int& C) { const int st = b / 1024, sb = b % 1024, swz = sb ^ (((sb >> 9) & 1) << 5); R = (st >> 1) * 16 + swz / 64; C = (st & 1) * 32 + (swz % 64) / 2; }
__host__ __device__ __forceinline__ int perm32(int rho) { const int n = rho >> 4, i = rho & 15; return 8 * (i >> 2) + 4 * n + (i & 3); }

struct Unit { int pm, pn; };
struct Gemm { const bf16_t* A; const bf16_t* Bt; int M, N, K; };

struct StaticOrder {
    int nM, nN, nwg, G, c;
    __host__ __device__ void init(int M, int N, int G_, int c_) { nM = M / BM; nN = N / BM; nwg = nM * nN; G = G_; c = c_; }
    __host__ __device__ bool next(int i, Unit& u) const {
        const long L = (long)i * G + c; if (L >= nwg) return false;
        int wgid = (int)L; { const int q = nwg / NXCD, r = nwg % NXCD, xcd = wgid % NXCD, off = wgid / NXCD; wgid = (xcd < r ? xcd * (q + 1) : r * (q + 1) + (xcd - r) * q) + off; }
        const int nig = WGM * nN, gid = wgid / nig, fm = gid * WGM, gsz = (nM - fm) < WGM ? (nM - fm) : WGM;
        u.pm = fm + ((wgid % nig) % gsz); u.pn = (wgid % nig) / gsz; return true;
    }
    __device__ __forceinline__ f32x4 a_ready(const Unit&) const { return (f32x4){0.f, 0.f, 0.f, 0.f}; }
    __device__ __forceinline__ void a_finish(const f32x4&) const {}
    __device__ __forceinline__ void done(const Unit&) const {}
};

struct RstdOrder : StaticOrder {
    const float* PART; const float* bias; int bstride; PG8_LAS float* sbuf; mutable int cnt;
    __device__ __forceinline__ f32x4 a_ready(const Unit& u) const {
        int t = threadIdx.x; asm volatile("" : "+v"(t)); f32x4 pend = (f32x4){0.f, 0.f, 0.f, 0.f};
        if (t < 256) pend = *(const f32x4*)(PART + ((size_t)u.pm * 256 + t) * 4);
        else if (t < 320) pend = *(const f32x4*)(bias + (size_t)(u.pm < 16 ? 0 : 1 + ((u.pm - 16) >> 4)) * bstride + u.pn * 256 + 4 * (t - 256));
        asm volatile("" ::: "memory"); return pend;
    }
    __device__ __forceinline__ void a_finish(const f32x4& pend) const {
        int t = threadIdx.x; asm volatile("" : "+v"(t));
        if (t < 256) sbuf[(cnt & 1) * 256 + t] = 1.0f / sqrtf(((pend[0] + pend[1]) + (pend[2] + pend[3])) * (1.0f / 1024.0f) + 1e-6f);
        else if (t < 320) *(PG8_LAS f32x4*)(sbuf + 512 + (cnt & 1) * 256 + 4 * (t - 256)) = pend;
        ++cnt;
    }
};
typedef float f32x2_c __attribute__((ext_vector_type(2))); typedef __bf16 bf16x2_c __attribute__((ext_vector_type(2)));
__device__ __forceinline__ unsigned cvt_pk_bf16(float lo, float hi) { f32x2_c v = {lo, hi}; bf16x2_c b = __builtin_convertvector(v, bf16x2_c); return __builtin_bit_cast(unsigned, b); }
typedef float f32x2 __attribute__((ext_vector_type(2)));
__device__ __forceinline__ float sigm(float x) { return __builtin_amdgcn_rcpf(1.f + __builtin_amdgcn_exp2f(-1.4426950408889634f * x)); }
typedef unsigned u32x2 __attribute__((ext_vector_type(2)));
__device__ __forceinline__ void row_rstd(const PG8_LAS float* srstd, int par, int wr, int fr, float (&rstd)[2][4]) {
#pragma unroll
    for (int ai = 0; ai < 2; ++ai)
#pragma unroll
        for (int m = 0; m < 4; ++m) rstd[ai][m] = srstd[par * 256 + ai * 128 + wr * 64 + m * 16 + fr];
}
struct EpiIn {
    static constexpr bool PERM = true, AFTER_DRAIN = false;
    unsigned char* wsb; float* outb; int layer; PG8_LAS float* srstd; mutable int ecnt;
    __device__ __forceinline__ void operator()(const f32x4 (&acc)[2][2][4][2], const Unit& u, int wr, int wc, int fr, int fq) const {
        float rstd[2][4]; row_rstd(srstd, ecnt & 1, wr, fr, rstd);
        const PG8_LAS float* bp = srstd + 512 + (ecnt & 1) * 256 + wc * 32 + 8 * fq; ++ecnt;
#define NV0 (acc[ai][bj][m][0] * rstd[ai][m] + bia0)
#define NV1 (acc[ai][bj][m][1] * rstd[ai][m] + bia1)
        bf16_t *Q = (bf16_t*)(wsb + WS_Q), *K = (bf16_t*)(wsb + WS_K), *VT = (bf16_t*)(wsb + WS_VT), *XB = (bf16_t*)(wsb + WS_XB), *YB = (bf16_t*)(wsb + WS_YB); float *outk = outb + OUT_K, *outv = outb + OUT_V;
        const int sec = u.pn >> 1; const unsigned colb = (u.pn & 1) * 256 + wc * 32 + 8 * fq, rowt = wr * 64 + fr;
        const int pm = u.pm; const bool ctx = pm < 16;
        if (sec == 2) {
            bf16_t* vt = VT + (unsigned)(4 * pm + wr) * 32768u + (colb >> 6) * 4096u + (colb & 63) * 64u + fr;
            float* ov = outv + (unsigned)(pm * 4 + layer) * 256u * 512u + rowt * 512u + colb;
#pragma unroll
            for (int bj = 0; bj < 2; ++bj) { const f32x4 bia0 = *(const PG8_LAS f32x4*)(bp + bj * 128), bia1 = *(const PG8_LAS f32x4*)(bp + bj * 128 + 4);
#pragma unroll
              for (int ai = 0; ai < 2; ++ai)
#pragma unroll
                for (int m = 0; m < 4; ++m) {
                    { const f32x4 v0 = NV0, v1 = NV1;
                        const unsigned w0 = cvt_pk_bf16(v0[0], v0[1]), w1 = cvt_pk_bf16(v0[2], v0[3]), w2 = cvt_pk_bf16(v1[0], v1[1]), w3 = cvt_pk_bf16(v1[2], v1[3]);
                        bf16_t* p = vt + (unsigned)(2 * ai) * 32768u + (unsigned)(bj * 2) * 4096u + m * 16;
                        p[0] = (bf16_t)w0; p[64] = (bf16_t)(w0 >> 16); p[128] = (bf16_t)w1; p[192] = (bf16_t)(w1 >> 16);
                        p[256] = (bf16_t)w2; p[320] = (bf16_t)(w2 >> 16); p[384] = (bf16_t)w3; p[448] = (bf16_t)(w3 >> 16);
                        if (ctx) { float* o = ov + (unsigned)(ai * 128 + m * 16) * 512u + bj * 128; *(f32x4*)o = v0; *(f32x4*)(o + 4) = v1; } }
                    asm volatile("" ::: "memory"); } }
        } else {
            bf16_t* base = (sec == 0 ? Q : sec == 3 ? XB : YB) + ((unsigned)pm * 256u + rowt) * 512u + colb;
            unsigned rstride = 512u, aistride = 128u * 512u, bjstride = 128u;
            if (sec == 1) { base = K + (unsigned)(4 * pm + wr) * 32768u + (colb >> 6) * 4096u + fr * 64u + (colb & 63); rstride = 64u; aistride = 2u * 32768u; bjstride = 2u * 4096u; }
            float* ok = outk + (unsigned)(pm * 4 + layer) * 256u * 512u + rowt * 512u + colb;
            const bool wk = sec == 1 && ctx;
#pragma unroll
            for (int bj = 0; bj < 2; ++bj) { const f32x4 bia0 = *(const PG8_LAS f32x4*)(bp + bj * 128), bia1 = *(const PG8_LAS f32x4*)(bp + bj * 128 + 4);
#pragma unroll
              for (int ai = 0; ai < 2; ++ai)
#pragma unroll
                for (int m = 0; m < 4; ++m) {
                    { const f32x4 v0 = NV0, v1 = NV1;
                        u32x4 w; w.x = cvt_pk_bf16(v0[0], v0[1]); w.y = cvt_pk_bf16(v0[2], v0[3]); w.z = cvt_pk_bf16(v1[0], v1[1]); w.w = cvt_pk_bf16(v1[2], v1[3]);
                        *(u32x4*)(base + ai * aistride + (unsigned)(m * 16) * rstride + bj * bjstride) = w;
                        if (wk) { float* o = ok + (unsigned)(ai * 128 + m * 16) * 512u + bj * 128; *(f32x4*)o = v0; *(f32x4*)(o + 4) = v1; } }
                    asm volatile("" ::: "memory"); } }
        }
    }
};
#undef NV0
#undef NV1
struct EpiRes {
    static constexpr bool PERM = true, AFTER_DRAIN = false;
    const float *base_lo, *base_hi; float* xout; int goff;
    unsigned char* wsb; int wp_idx; PG8_LAS float* sred;
    __device__ __forceinline__ void operator()(const f32x4 (&acc)[2][2][4][2], const Unit& u, int wr, int wc, int fr, int fq) const {
        const float* wprime = wp_idx >= 0 ? (const float*)(wsb + WS_WP) + (size_t)wp_idx * 9 * 1024 : (const float*)nullptr; bf16_t* AN = (bf16_t*)(wsb + WS_HN); float* PART = (float*)(wsb + WS_PART);
        const int pm = u.pm; const int mg = pm < 16 ? 0 : 1 + ((pm - 16) >> 4);
        const float* bs = pm < 16 ? base_lo + (size_t)pm * 256 * DM : base_hi + (size_t)(pm - 16) * 256 * DM;
        float* xo = xout + (size_t)pm * 256 * DM;
        const int col0 = u.pn * 256 + wc * 32 + 8 * fq; const float* gp = (const float*)(wsb + WS_MODS) + mg * 6144 + goff + col0;
        float ss[2][4];
#pragma unroll
        for (int ai = 0; ai < 2; ++ai)
#pragma unroll
            for (int m = 0; m < 4; ++m) ss[ai][m] = 0.f;
#pragma unroll
        for (int bj = 0; bj < 2; ++bj) {
            const f32x4 g0 = *(const f32x4*)(gp + bj * 128), g1 = *(const f32x4*)(gp + bj * 128 + 4);
            f32x4 w0 = g0, w1 = g1; if (wprime) { const float* wp = wprime + mg * 1024 + col0 + bj * 128; w0 = *(const f32x4*)wp; w1 = *(const f32x4*)(wp + 4); }
#pragma unroll
            for (int ai = 0; ai < 2; ++ai)
#pragma unroll
                for (int m = 0; m < 4; ++m) { unsigned off = (unsigned)(wr * 64 + fr + ai * 128 + m * 16) * DM + col0 + bj * 128; asm volatile("" : "+v"(off));
                    bf16_t* xrow = (bf16_t*)xo + 2u * (off - (col0 + bj * 128)) + 1024 + col0 + bj * 128;
                    f32x4 b0, b1;
                    if (base_lo) { b0 = *(const f32x4*)(bs + off); b1 = *(const f32x4*)(bs + off + 4); }
                    else { const u32x4 rw = *(const u32x4*)xrow; b0 = (f32x4){__uint_as_float(rw.x << 16), __uint_as_float(rw.x & 0xffff0000u), __uint_as_float(rw.y << 16), __uint_as_float(rw.y & 0xffff0000u)};
                        b1 = (f32x4){__uint_as_float(rw.z << 16), __uint_as_float(rw.z & 0xffff0000u), __uint_as_float(rw.w << 16), __uint_as_float(rw.w & 0xffff0000u)}; }
                    const f32x4 x0 = b0 + g0 * acc[ai][bj][m][0], x1 = b1 + g1 * acc[ai][bj][m][1];
                    { u32x4 xw; xw.x = cvt_pk_bf16(x0[0], x0[1]); xw.y = cvt_pk_bf16(x0[2], x0[3]); xw.z = cvt_pk_bf16(x1[0], x1[1]); xw.w = cvt_pk_bf16(x1[2], x1[3]); *(u32x4*)xrow = xw; }
                    if (wprime) { ss[ai][m] += ((x0[0] * x0[0] + x0[1] * x0[1]) + (x0[2] * x0[2] + x0[3] * x0[3])) + ((x1[0] * x1[0] + x1[1] * x1[1]) + (x1[2] * x1[2] + x1[3] * x1[3]));
                        const f32x4 a0 = x0 * w0, a1 = x1 * w1; u32x4 w; w.x = cvt_pk_bf16(a0[0], a0[1]); w.y = cvt_pk_bf16(a0[2], a0[3]); w.z = cvt_pk_bf16(a1[0], a1[1]); w.w = cvt_pk_bf16(a1[2], a1[3]);
                        *(u32x4*)(AN + (size_t)pm * 256 * DM + off) = w; }
                    if (m == 3) asm volatile("" ::: "memory"); }
        }
        if (wp_idx >= 0) {
#pragma unroll
            for (int ai = 0; ai < 2; ++ai)
#pragma unroll
                for (int m = 0; m < 4; ++m) { float t = ss[ai][m]; t += __shfl_xor(t, 16); t += __shfl_xor(t, 32);
                    if (fq == 0) sred[(wr * 64 + fr + ai * 128 + m * 16) * 4 + wc] = t; }
            asm volatile("s_waitcnt lgkmcnt(0)" ::: "memory"); __builtin_amdgcn_s_barrier(); asm volatile("" ::: "memory");
            const int t_ = (wr * 4 + wc) * 64 + fq * 16 + fr;
            if (t_ < 256) { const f32x4 v = *(const PG8_LAS f32x4*)(sred + t_ * 4); PART[((size_t)pm * 256 + t_) * 4 + u.pn] = (v[0] + v[1]) + (v[2] + v[3]); }
        }
    }
};
struct EpiGU {
    static constexpr bool PERM = true, AFTER_DRAIN = false;
    bf16_t* ACT; PG8_LAS float* srstd; mutable int ecnt;
    __device__ __forceinline__ void operator()(const f32x4 (&acc)[2][2][4][2], const Unit& u, int wr, int wc, int fr, int fq) const {
        const int col0 = u.pn * 128 + wc * 32 + 8 * fq;
        float rstd[2][4]; row_rstd(srstd, ecnt & 1, wr, fr, rstd);
        const PG8_LAS float* bp = srstd + 512 + (ecnt & 1) * 256 + wc * 32 + 8 * fq; ++ecnt;
        f32x4 bg[2], bu[2];
#pragma unroll
        for (int n = 0; n < 2; ++n) { bg[n] = *(const PG8_LAS f32x4*)(bp + 4 * n); bu[n] = *(const PG8_LAS f32x4*)(bp + 128 + 4 * n); }
#pragma unroll
        for (int ai = 0; ai < 2; ++ai)
#pragma unroll
            for (int m = 0; m < 4; ++m) { const size_t row = (size_t)u.pm * 256 + wr * 64 + fr + ai * 128 + m * 16; float o[8];
#pragma unroll
                for (int n = 0; n < 2; ++n) { const f32x4 gt = acc[ai][0][m][n] * rstd[ai][m] + bg[n], up = acc[ai][1][m][n] * rstd[ai][m] + bu[n];
#pragma unroll
                    for (int e = 0; e < 4; ++e) o[4 * n + e] = gt[e] * sigm(gt[e]) * up[e]; }
                u32x4 w; w.x = cvt_pk_bf16(o[0], o[1]); w.y = cvt_pk_bf16(o[2], o[3]); w.z = cvt_pk_bf16(o[4], o[5]); w.w = cvt_pk_bf16(o[6], o[7]);
                *(u32x4*)(ACT + row * DFF + col0) = w; }
    }
};
template <class Epi, class Sched, bool ALIGN_EPI = false, bool SP2 = false>
__device__ __forceinline__ void gemm_phase(PG8_LAS unsigned char* lds, const Gemm g, const Sched& S, const Epi& E) {
    int tid = threadIdx.x; asm volatile("" : "+v"(tid));
    const int wid = __builtin_amdgcn_readfirstlane(tid >> 6), lane = tid & 63, wr = wid >> 2, wc = wid & 3, fr = lane & 15, fq = lane >> 4;
    const int K = g.K, nt = K / BK;
    unsigned voffA[2], voffB[2];
#pragma unroll
    for (int i = 0; i < 2; ++i) { int R, C; stage_rc(tid * 16 + i * 8192, R, C); const int Rb = Epi::PERM ? ((R & ~31) + perm32(R & 31)) : R;
        voffA[i] = (unsigned)(R * K + C) * 2u; voffB[i] = (unsigned)(Rb * K + C) * 2u; }
    const size_t kstep = (size_t)(BK * 2);
    const size_t hstep = (size_t)HALF * K * 2;
    const size_t tstep = 2 * hstep;
    const unsigned ldsw = (unsigned)wid * 1024u;
    const int aoff = lds_byte(wr * 64 + fr, fq * 8), boff = lds_byte(wc * 32 + fr, fq * 8);
#define PG8_SA(b, h) (((b) * 2 + (h)) * HTB)
#define PG8_SB(b, h) ((4 + (b) * 2 + (h)) * HTB)
#define PG8_STAGE(bufoff, gbase, voff) do { _Pragma("unroll") for (int _i = 0; _i < 2; ++_i) \
        __builtin_amdgcn_global_load_lds((const unsigned*)((const char*)(gbase) + (voff)[_i]), (PG8_LAS unsigned*)(lds + (bufoff) + ldsw + _i * 8192), 16, 0, 0); } while (0)
#define PG8_LDA(dst, b, h) do { _Pragma("unroll") for (int m = 0; m < 4; ++m) _Pragma("unroll") for (int k = 0; k < 2; ++k) dst[m][k] = *(const PG8_LAS bf16x8*)(lds + PG8_SA(b, h) + aoff + m * 2048 + k * 1024); } while (0)
#define PG8_LDB(dst, b, h) do { _Pragma("unroll") for (int n = 0; n < 2; ++n) _Pragma("unroll") for (int k = 0; k < 2; ++k) dst[n][k] = *(const PG8_LAS bf16x8*)(lds + PG8_SB(b, h) + boff + n * 2048 + k * 1024); } while (0)
#define PG8_MMA(ai, bj, At, Bt) do { __builtin_amdgcn_s_setprio(1); _Pragma("unroll") for (int m = 0; m < 4; ++m) _Pragma("unroll") for (int n = 0; n < 2; ++n) _Pragma("unroll") for (int k = 0; k < 2; ++k) \
        acc[ai][bj][m][n] = __builtin_amdgcn_mfma_f32_16x16x32_bf16(Bt[n][k], At[m][k], acc[ai][bj][m][n], 0, 0, 0); __builtin_amdgcn_s_setprio(0); } while (0)
#define PG8_WAIT_V(n) asm volatile("s_waitcnt vmcnt(" #n ")" ::: "memory")
#define PG8_WAIT_L(n) asm volatile("s_waitcnt lgkmcnt(" #n ")" ::: "memory")
#define PG8_BAR __builtin_amdgcn_s_barrier()
#define PG8_SCHED __builtin_amdgcn_sched_barrier(0)
    Unit cur, nxt; int ui = 0;
    if (!S.next(0, cur)) return;
    f32x4 acc[2][2][4][2];
#pragma unroll
    for (int a = 0; a < 2; ++a)
#pragma unroll
        for (int b = 0; b < 2; ++b)
#pragma unroll
            for (int m = 0; m < 4; ++m)
#pragma unroll
                for (int n = 0; n < 2; ++n) acc[a][b][m][n] = (f32x4){0.f, 0.f, 0.f, 0.f};
    bf16x8 At[4][2], B0[2][2], B1[2][2];
    const char* cA = (const char*)g.A + (size_t)cur.pm * tstep; const char* cB = (const char*)g.Bt + (size_t)cur.pn * tstep;
    f32x4 hookv = S.a_ready(cur); S.a_finish(hookv);
    if constexpr (SP2) {
        PG8_STAGE(PG8_SB(0, 0), cB, voffB); PG8_STAGE(PG8_SB(0, 1), cB + hstep, voffB); PG8_STAGE(PG8_SA(0, 0), cA, voffA); PG8_STAGE(PG8_SA(0, 1), cA + hstep, voffA);
        if (wr == 1) PG8_BAR;
        PG8_WAIT_V(2); PG8_BAR;
        PG8_STAGE(PG8_SB(1, 0), cB + kstep, voffB); PG8_STAGE(PG8_SA(1, 0), cA + kstep, voffA); PG8_STAGE(PG8_SB(1, 1), cB + hstep + kstep, voffB);
        PG8_WAIT_V(6); PG8_BAR;
    } else {
        PG8_STAGE(PG8_SB(0, 0), cB, voffB); PG8_STAGE(PG8_SA(0, 0), cA, voffA); PG8_STAGE(PG8_SB(0, 1), cB + hstep, voffB); PG8_STAGE(PG8_SA(0, 1), cA + hstep, voffA);
        if (wr == 1) PG8_BAR;
        PG8_WAIT_V(4); PG8_BAR;
        PG8_STAGE(PG8_SB(1, 0), cB + kstep, voffB); PG8_STAGE(PG8_SA(1, 0), cA + kstep, voffA); PG8_STAGE(PG8_SB(1, 1), cB + hstep + kstep, voffB);
        PG8_WAIT_V(6); PG8_BAR;
    }
    for (;;) {
        const bool has_next = S.next(ui + 1, nxt);
        const char* nA = has_next ? (const char*)g.A + (size_t)nxt.pm * tstep : cA; const char* nB = has_next ? (const char*)g.Bt + (size_t)nxt.pn * tstep : cB;
        for (int t = 0; t < nt; t += 2) {
            const bool last = (t == nt - 2);
            const char* a1 = cA + (size_t)(t + 1) * kstep;
            const char* a2 = last ? nA : cA + (size_t)(t + 2) * kstep; const char* b2 = last ? nB : cB + (size_t)(t + 2) * kstep;
            const char* a3 = a2 + kstep; const char* b3 = b2 + kstep;
            if (last && has_next) hookv = S.a_ready(nxt);
            if constexpr (SP2) {
            PG8_LDB(B0, 0, 0); PG8_LDB(B1, 0, 1); PG8_SCHED; PG8_LDA(At, 0, 0); PG8_STAGE(PG8_SA(1, 1), a1 + hstep, voffA);
            PG8_WAIT_V(8); PG8_WAIT_L(0); PG8_BAR; PG8_MMA(0, 0, At, B0); PG8_MMA(0, 1, At, B1); PG8_BAR; PG8_SCHED;
            PG8_LDA(At, 0, 1); PG8_STAGE(PG8_SB(0, 0), b2, voffB); PG8_STAGE(PG8_SB(0, 1), b2 + hstep, voffB); PG8_STAGE(PG8_SA(0, 0), a2, voffA);
            PG8_WAIT_V(8); PG8_WAIT_L(0); PG8_BAR; PG8_MMA(1, 0, At, B0); PG8_MMA(1, 1, At, B1); PG8_BAR; PG8_SCHED;
            PG8_LDB(B0, 1, 0); PG8_LDB(B1, 1, 1); PG8_SCHED; PG8_LDA(At, 1, 0); PG8_STAGE(PG8_SA(0, 1), a2 + hstep, voffA);
            PG8_WAIT_V(8); PG8_WAIT_L(0); PG8_BAR; PG8_MMA(0, 0, At, B0); PG8_MMA(0, 1, At, B1); PG8_BAR; PG8_SCHED;
            PG8_LDA(At, 1, 1); PG8_STAGE(PG8_SB(1, 0), b3, voffB); PG8_STAGE(PG8_SB(1, 1), b3 + hstep, voffB); PG8_STAGE(PG8_SA(1, 0), a3, voffA);
            PG8_WAIT_V(8); PG8_WAIT_L(0); PG8_BAR; PG8_MMA(1, 0, At, B0); PG8_MMA(1, 1, At, B1); PG8_BAR; PG8_SCHED;
            } else {
            PG8_LDB(B0, 0, 0); PG8_SCHED; PG8_LDA(At, 0, 0); PG8_STAGE(PG8_SA(1, 1), a1 + hstep, voffA);
            PG8_WAIT_L(8); PG8_BAR; PG8_WAIT_L(0); PG8_MMA(0, 0, At, B0); PG8_BAR; PG8_SCHED;
            PG8_LDB(B1, 0, 1); PG8_STAGE(PG8_SB(0, 0), b2, voffB);
            PG8_BAR; PG8_WAIT_L(0); PG8_MMA(0, 1, At, B1); PG8_BAR;
            PG8_LDA(At, 0, 1); PG8_STAGE(PG8_SA(0, 0), a2, voffA);
            PG8_BAR; PG8_WAIT_L(0); PG8_MMA(1, 0, At, B0); PG8_BAR; PG8_SCHED;
            PG8_STAGE(PG8_SB(0, 1), b2 + hstep, voffB);
            PG8_WAIT_V(6); PG8_BAR; PG8_MMA(1, 1, At, B1); PG8_BAR;
            PG8_LDB(B0, 1, 0); PG8_SCHED; PG8_LDA(At, 1, 0); PG8_STAGE(PG8_SA(0, 1), a2 + hstep, voffA);
            PG8_WAIT_L(8); PG8_BAR; PG8_WAIT_L(0); PG8_MMA(0, 0, At, B0); PG8_BAR; PG8_SCHED;
            PG8_LDB(B1, 1, 1); PG8_STAGE(PG8_SB(1, 0), b3, voffB);
            PG8_BAR; PG8_WAIT_L(0); PG8_MMA(0, 1, At, B1); PG8_BAR;
            PG8_LDA(At, 1, 1); PG8_STAGE(PG8_SA(1, 0), a3, voffA);
            PG8_BAR; PG8_WAIT_L(0); PG8_MMA(1, 0, At, B0); PG8_BAR; PG8_SCHED;
            PG8_STAGE(PG8_SB(1, 1), b3 + hstep, voffB);
            PG8_WAIT_V(6); PG8_BAR; PG8_MMA(1, 1, At, B1); PG8_BAR;
            }
            if (last && has_next) S.a_finish(hookv);
        }
        if constexpr (ALIGN_EPI) { if (wr == 0) PG8_BAR; }
        if constexpr (!Epi::AFTER_DRAIN) { E(acc, cur, wr, wc, fr, fq); S.done(cur); }
        if (!has_next) break;
#pragma unroll
        for (int a = 0; a < 2; ++a)
#pragma unroll
            for (int b = 0; b < 2; ++b)
#pragma unroll
                for (int m = 0; m < 4; ++m)
#pragma unroll
                    for (int n = 0; n < 2; ++n) acc[a][b][m][n] = (f32x4){0.f, 0.f, 0.f, 0.f};
        cur = nxt; cA = nA; cB = nB; ++ui;
        if constexpr (ALIGN_EPI) { if (wr == 1) PG8_BAR; }
    }
    PG8_WAIT_V(0);
    if constexpr (!ALIGN_EPI) { if (wr == 0) PG8_BAR; }
    PG8_BAR;
    if constexpr (Epi::AFTER_DRAIN) { E.fused(acc, cur, wr, wc, fr, fq, lds, wid, lane); S.done(cur); }
#undef PG8_SA
#undef PG8_SB
#undef PG8_STAGE
#undef PG8_LDA
#undef PG8_LDB
#undef PG8_MMA
#undef PG8_WAIT_V
#undef PG8_WAIT_L
#undef PG8_BAR
#undef PG8_SCHED
}
}
#define LAS __attribute__((address_space(3)))
typedef unsigned short bf16;
typedef short bf16x8 __attribute__((ext_vector_type(8)));
typedef short s16x4 __attribute__((ext_vector_type(4)));
typedef float f32x4 __attribute__((ext_vector_type(4)));
typedef unsigned u32x4 __attribute__((ext_vector_type(4)));
typedef unsigned u32x2 __attribute__((ext_vector_type(2)));
constexpr int LDS_BYTES = 147456;
#define LDS_FENCE() asm volatile("s_waitcnt lgkmcnt(0)" ::: "memory")
constexpr float LOG2E = 1.4426950408889634f;
using pg8::cvt_pk_bf16; using pg8::sigm;
__device__ __forceinline__ float ex2(float x) { return __builtin_amdgcn_exp2f(x); }
__device__ __forceinline__ float wave_sum(float v) {
#pragma unroll
    for (int o = 1; o < 64; o <<= 1) v += __shfl_xor(v, o);
    return v;
}
struct Params { const float* in[25]; float* out; unsigned char* ws; int ph_lo, ph_hi; };

typedef __attribute__((address_space(1))) unsigned gu32;
#define XB_TMO      128
#define XB_XCNT(j)  (256  + 64 * (j))
#define XB_XSUB(j)  (1280 + 64 * (j))
#define XB_XGEN(j)  (2304 + 64 * (j))
#define XB_TOP      3328
#define XB_TOPGEN   3392
#define XCD_BAR_WORDS 3456
#define XB_SPIN_CAP (1u << 18)

__device__ __forceinline__ unsigned xb_ld(unsigned* p)              { return __hip_atomic_load(p, __ATOMIC_RELAXED, __HIP_MEMORY_SCOPE_AGENT); }
__device__ __forceinline__ unsigned xb_add(unsigned* p, unsigned v) { return __hip_atomic_fetch_add(p, v, __ATOMIC_RELAXED, __HIP_MEMORY_SCOPE_AGENT); }
__device__ __forceinline__ unsigned xb_xcc_id() { return (unsigned)__builtin_amdgcn_s_getreg((3 << 11) | 20) & 0xFu; }
#define XB_SPIN(cond, bar) do { unsigned _sp = 0; while (cond) { __builtin_amdgcn_s_sleep(1); \
    if ((++_sp & 255u) == 0u) { if (xb_ld(&(bar)[XB_TMO])) break; if (_sp > XB_SPIN_CAP) { atomicAdd(&(bar)[XB_TMO], 1u); break; } } } } while (0)

struct XcdBarrier {
    unsigned* bar; unsigned x;
    volatile LAS unsigned* st;
};

__device__ __forceinline__ XcdBarrier xcd_barrier_post(unsigned* bar, volatile LAS unsigned* st) {
    XcdBarrier b; b.bar = bar; b.x = xb_xcc_id(); b.st = st;
    if (threadIdx.x == 0) st[2] = xb_add(&bar[XB_XCNT(b.x)], 1u);
    return b;
}
__device__ __forceinline__ void xcd_barrier_complete(unsigned* bar, unsigned x, unsigned& nloc, unsigned& nx) {
    const unsigned G = gridDim.x * gridDim.y * gridDim.z;
    unsigned sum, cnt, mine, sp = 0u;
    for (;;) {
        sum = 0u; cnt = 0u; mine = 0u;
#pragma unroll
        for (unsigned j = 0; j < 16; ++j) { const unsigned c = xb_ld(&bar[XB_XCNT(j)]); sum += c; cnt += (c > 0u) ? 1u : 0u; mine = (j == x) ? c : mine; }
        if (sum == G) break;
        __builtin_amdgcn_s_sleep(1);
        if ((++sp & 255u) == 0u) { if (xb_ld(&bar[XB_TMO])) break; if (sp > XB_SPIN_CAP) { atomicAdd(&bar[XB_TMO], 1u); break; } }
    }
    nloc = mine > 0u ? mine : 1u; nx = cnt > 0u ? cnt : 1u;
}

__device__ __forceinline__ void xcd_barrier(const XcdBarrier& b) {
    asm volatile("s_waitcnt vmcnt(0)" ::: "memory");
    __syncthreads();
    if (threadIdx.x == 0) {
        unsigned* bar = b.bar;
        __builtin_amdgcn_s_waitcnt(0);
        unsigned nloc = b.st[0], nx = b.st[1];
        if (nloc == 0u) { xcd_barrier_complete(bar, b.x, nloc, nx); b.st[0] = nloc; b.st[1] = nx; }
        const unsigned old = xb_add(&bar[XB_XSUB(b.x)], 1u);
        const unsigned gen = old / nloc;
        if (old + 1u == (gen + 1u) * nloc) {
            __builtin_amdgcn_fence(__ATOMIC_RELEASE, "agent");
            asm volatile("s_waitcnt vmcnt(0)" ::: "memory");
            const unsigned og = xb_add(&bar[XB_TOP], 1u);
            const unsigned tg = og / nx;
            if (og + 1u == (tg + 1u) * nx) xb_add(&bar[XB_TOPGEN], 1u);
            else XB_SPIN(xb_ld(&bar[XB_TOPGEN]) == tg, bar);
            __builtin_amdgcn_fence(__ATOMIC_ACQUIRE, "agent");
            xb_add(&bar[XB_XGEN(b.x)], 1u);
            asm volatile("s_waitcnt vmcnt(0)" ::: "memory");
        } else {
            XB_SPIN(xb_ld(&bar[XB_XGEN(b.x)]) == gen, bar);
            __builtin_amdgcn_fence(__ATOMIC_ACQUIRE, "agent");
            asm volatile("s_waitcnt vmcnt(0)" ::: "memory");
        }
    }
    __syncthreads();
}
__device__ __forceinline__ void transpose_item(const float* W, int N, int k0, int n0, bf16* WT, int Kd, int drow0, LAS float* scr, int lane) {
#pragma unroll 8
    for (int i = 0; i < 32; ++i) { const int kk = 2 * i + (lane >> 5); scr[kk * 33 + (lane & 31)] = W[(size_t)(k0 + kk) * N + n0 + (lane & 31)]; }
    LDS_FENCE();
    const int c = lane & 7;
#pragma unroll
    for (int j = 0; j < 4; ++j) { const int n = (lane >> 3) + 8 * j; const LAS float* s = scr + (8 * c) * 33 + n;
        u32x4 o; o.x = cvt_pk_bf16(s[0 * 33], s[1 * 33]); o.y = cvt_pk_bf16(s[2 * 33], s[3 * 33]); o.z = cvt_pk_bf16(s[4 * 33], s[5 * 33]); o.w = cvt_pk_bf16(s[6 * 33], s[7 * 33]);
        *(u32x4*)(WT + (size_t)(drow0 + n) * Kd + k0 + 8 * c) = o; }
    LDS_FENCE();
}
__device__ __forceinline__ void convert_layer(const Params& P, unsigned char* ws, int l, LAS float* scr, int lane, int widx, int nw) {
    bf16 *WIN = (bf16*)(ws + WS_WIN), *WOUT = (bf16*)(ws + WS_WOUT), *WGU = (bf16*)(ws + WS_WGU), *WDN = (bf16*)(ws + WS_WDN);
    constexpr int PER_L = 1280 + 512 + 1408 + 1408 + 1408;
    for (int it = widx; it < PER_L; it += nw) { int r = it;
        if (r < 1280) { const int kb = r / 80, nb = r % 80; transpose_item(P.in[11] + (size_t)l * 1024 * 2560, 2560, 64 * kb, 32 * nb, WIN + (size_t)l * 2560 * 1024, 1024, 32 * nb, scr, lane); continue; } r -= 1280;
        if (r < 512) { const int kb = r / 32, nb = r % 32; transpose_item(P.in[12] + (size_t)l * 1024 * 1024, 1024, 64 * kb, 32 * nb, WOUT + (size_t)l * 1024 * 1024, 1024, 32 * nb, scr, lane); continue; } r -= 512;
        if (r < 2816) { const int up = r >= 1408; if (up) r -= 1408; const int kb = r / 88, nb = r % 88, n0 = 32 * nb;
            transpose_item(P.in[up ? 22 : 21] + (size_t)l * 1024 * 2816, 2816, 64 * kb, n0, WGU + (size_t)l * 5632 * 1024, 1024, 256 * (n0 >> 7) + (n0 & 127) + (up ? 128 : 0), scr, lane); continue; } r -= 2816;
        { const int kb = r / 32, nb = r % 32; transpose_item(P.in[23] + (size_t)l * 2816 * 1024, 1024, 64 * kb, 32 * nb, WDN + (size_t)l * 1024 * 2816, 2816, 32 * nb, scr, lane); }
    }
}
__device__ __forceinline__ void prologue(const Params& P, LAS unsigned char* lds, int tid, int wave, int lane) {
    unsigned char* ws = P.ws;
    {
        LAS float* S = (LAS float*)(lds + 67584);
        LAS float* R = (LAS float*)(lds + 67584 + 36864);
        for (int i = tid; i < 9 * 1024; i += 512) { const int v = i >> 10, k = i & 1023; const float x = v == 0 ? P.in[6][k] : P.in[5][(v - 1) * 1024 + k]; S[i] = x * sigm(x); }
        __syncthreads();
        float* MODS = (float*)(ws + WS_MODS);
        for (int it = blockIdx.x; it < 4 * 96; it += gridDim.x) {
            const int l = it / 96, cb = it % 96; const float* w = P.in[7] + (size_t)l * 1024 * 6144 + cb * 64 + lane;
            float a[9];
#pragma unroll
            for (int v = 0; v < 9; ++v) a[v] = 0.f;
            const int kb = wave * 128;
#pragma unroll 4
            for (int k = 0; k < 128; ++k) { const float wv = w[(size_t)(kb + k) * 6144];
#pragma unroll
                for (int v = 0; v < 9; ++v) a[v] += S[v * 1024 + kb + k] * wv; }
#pragma unroll
            for (int v = 0; v < 9; ++v) R[(wave * 9 + v) * 64 + lane] = a[v];
            __syncthreads();
            for (int o = tid; o < 9 * 64; o += 512) { const int v = o >> 6, cidx = o & 63; float s = 0.f;
#pragma unroll
                for (int w8 = 0; w8 < 8; ++w8) s += R[(w8 * 9 + v) * 64 + cidx];
                MODS[((size_t)l * 9 + v) * 6144 + cb * 64 + cidx] = s + P.in[8][l * 6144 + cb * 64 + cidx]; }
            __syncthreads();
        }
    }
    {
        LAS float* scr = (LAS float*)(lds + wave * 8448);
        const int gw = blockIdx.x * 8 + wave, ngw = gridDim.x * 8;
        bf16* CVT = (bf16*)(ws + WS_CVT);
        convert_layer(P, ws, 0, scr, lane, gw, ngw);
        for (int r = gw; r < 2048; r += ngw) { const int bl = r >> 6, rr = r & 63, kb = rr >> 4, nb = rr & 15;
            transpose_item(P.in[3] + (size_t)bl * 256 * 512, 512, 64 * kb, 32 * nb, CVT + ((size_t)(bl * 4 + kb) * 8 + (nb >> 1)) * 4096 - 64 * kb, 64, (nb & 1) * 32, scr, lane); }
    }
    {
        const int gt = blockIdx.x * 512 + tid, ngt = gridDim.x * 512;
        bf16* CK = (bf16*)(ws + WS_CK);
        for (int i = gt; i < 8 * 4 * 256 * 512 / 8; i += ngt) { const f32x4 a = *(const f32x4*)(P.in[2] + (size_t)i * 8), b = *(const f32x4*)(P.in[2] + (size_t)i * 8 + 4);
            u32x4 w; w.x = cvt_pk_bf16(a[0], a[1]); w.y = cvt_pk_bf16(a[2], a[3]); w.z = cvt_pk_bf16(b[0], b[1]); w.w = cvt_pk_bf16(b[2], b[3]); const int e = i * 8, col = e & 511, rowi = e >> 9, tok = rowi & 63, chunk = rowi >> 6; *(u32x4*)(CK + ((size_t)(chunk * 8 + (col >> 6)) * 64 + tok) * 64 + (col & 63)) = w; }
        bf16* WL = (bf16*)(ws + WS_LRUW);
        for (int o = gt; o < 4 * 2 * 2 * 8 * 4096; o += ngt) { const int j = o & 63, k = (o >> 6) & 63, n = (o >> 12) & 7, ri = (o >> 15) & 1, ld = o >> 16;
            const float v = P.in[ri ? 19 : 17][((size_t)(ld * 8 + n) * 64 + j) * 64 + k]; WL[o] = (bf16)(cvt_pk_bf16(v, 0.f) & 0xffffu); }
    }
}
__device__ __forceinline__ void norm_mod_phase(const float* x_lo, const float* x_hi, const float* normw, const float* mods, int shoff, int scoff, bf16* HN, int gw, int ngw, int lane) {
    for (int row = gw; row < MTOK; row += ngw) {
        const float* xr = row < NCTX ? x_lo + (size_t)row * DM : x_hi + (size_t)(row - NCTX) * DM;
        const int mg = row < NCTX ? 0 : 1 + ((row - NCTX) >> 12);
        f32x4 v[4]; float s = 0.f;
#pragma unroll
        for (int j = 0; j < 4; ++j) { v[j] = *(const f32x4*)(xr + 256 * j + 4 * lane); s += (v[j][0] * v[j][0] + v[j][1] * v[j][1]) + (v[j][2] * v[j][2] + v[j][3] * v[j][3]); }
        const float rstd = 1.0f / sqrtf(wave_sum(s) * (1.f / DM) + 1e-6f);
        const float* mp = mods + mg * 6144;
#pragma unroll
        for (int j = 0; j < 4; ++j) { const int c = 256 * j + 4 * lane; const f32x4 w = *(const f32x4*)(normw + c), sc = *(const f32x4*)(mp + scoff + c), sh = *(const f32x4*)(mp + shoff + c);
            const f32x4 o = (v[j] * rstd * w) * (sc + 1.0f) + sh; u32x2 pk; pk.x = cvt_pk_bf16(o[0], o[1]); pk.y = cvt_pk_bf16(o[2], o[3]); *(u32x2*)(HN + (size_t)row * DM + c) = pk; }
    }
}
__device__ __forceinline__ void final_norm_phase(float* x, const float* normw, int gw, int ngw, int lane) {
    for (int row = gw; row < MTOK; row += ngw) {
        float* xr = x + (size_t)row * DM; const bf16* xb = (const bf16*)xr + 1024; f32x4 v[4]; float s = 0.f;
#pragma unroll
        for (int j = 0; j < 4; ++j) { const u32x2 rw = *(const u32x2*)(xb + 256 * j + 4 * lane);
            v[j] = (f32x4){__uint_as_float(rw.x << 16), __uint_as_float(rw.x & 0xffff0000u), __uint_as_float(rw.y << 16), __uint_as_float(rw.y & 0xffff0000u)};
            s += (v[j][0] * v[j][0] + v[j][1] * v[j][1]) + (v[j][2] * v[j][2] + v[j][3] * v[j][3]); }
        const float rstd = 1.0f / sqrtf(wave_sum(s) * (1.f / DM) + 1e-6f);
        asm volatile("s_waitcnt vmcnt(0)" ::: "memory");
#pragma unroll
        for (int j = 0; j < 4; ++j) { const int c = 256 * j + 4 * lane; const f32x4 w = *(const f32x4*)(normw + c); *(f32x4*)(xr + c) = v[j] * rstd * w; }
    }
}
#define MFMA16(a, b, c) __builtin_amdgcn_mfma_f32_16x16x32_bf16((a), (b), (c), 0, 0, 0)
#define USED(kt, qtg) (!LOCAL || ((kt) - (qtg) <= 1 && (qtg) - (kt) <= 1))
#define PIN_MEM() asm volatile("" ::: "memory")
__device__ __forceinline__ void attn_load_k(const bf16* Kp, bf16x8 (&kf)[4][2], int g, int c16) {
#pragma unroll
    for (int kt = 0; kt < 4; ++kt) { const bf16* kr = Kp + (16 * kt + c16) * 64 + 8 * g; kf[kt][0] = *(const bf16x8*)kr; kf[kt][1] = *(const bf16x8*)(kr + 32); }
}
__device__ __forceinline__ void attn_load_v(const bf16* VTp, int vstride, s16x4 (&va)[2][4], s16x4 (&vb)[2][4], int g, int c16) {
#pragma unroll
    for (int kp = 0; kp < 2; ++kp)
#pragma unroll
        for (int dt = 0; dt < 4; ++dt) { const bf16* vr = VTp + (16 * dt + c16) * 64 + 32 * kp + 4 * g; va[kp][dt] = *(const s16x4*)vr; vb[kp][dt] = *(const s16x4*)(vr + 16); }
}
template <bool LOCAL, int QH>
__device__ __forceinline__ void attn_qk(f32x4 (&S)[4][2], const bf16x8 (&kf)[4][2], const bf16x8 (&qf)[2][2]) {
    __builtin_amdgcn_s_setprio(1);
#pragma unroll
    for (int kt = 0; kt < 4; ++kt)
#pragma unroll
        for (int qi = 0; qi < 2; ++qi) if (USED(kt, 2 * QH + qi)) {
            f32x4 a = (f32x4){0.f, 0.f, 0.f, 0.f}; a = MFMA16(kf[kt][0], qf[qi][0], a); a = MFMA16(kf[kt][1], qf[qi][1], a); S[kt][qi] = a; }
    __builtin_amdgcn_s_setprio(0);
}
template <bool LOCAL, int QH>
__device__ __forceinline__ void attn_softmax(f32x4 (&S)[4][2], f32x4 (&O)[4][2], float (&mrow)[2], f32x4 (&L)[2], const LAS float* rp, const int (&lo)[2], bf16x8 (&pb)[2][2]) {
    constexpr float C1 = 0.125f * LOG2E;
    float mnew[2]; bool grow = false;
#pragma unroll
    for (int qi = 0; qi < 2; ++qi) { const int qtg = 2 * QH + qi;
        float mx = -1e30f;
#pragma unroll
        for (int kt = 0; kt < 4; ++kt) if (USED(kt, qtg)) {
#pragma unroll
            for (int j = 0; j < 4; ++j) {
                if (LOCAL) { float t = __builtin_fmaf(S[kt][qi][j], C1, rp[16 * (kt - qtg) + j]); t = ((unsigned)(16 * kt + j - lo[qi]) < 16u) ? t : -1e30f; S[kt][qi][j] = t; mx = fmaxf(mx, t); }
                else mx = fmaxf(mx, S[kt][qi][j]); } }
        if (!LOCAL) mx *= C1;
        mx = fmaxf(mx, __shfl_xor(mx, 16)); mx = fmaxf(mx, __shfl_xor(mx, 32));
        const bool gq = mx > mrow[qi] + 8.0f; mnew[qi] = gq ? mx : mrow[qi]; grow = grow || gq;
    }
    if (__any(grow)) {
#pragma unroll
        for (int qi = 0; qi < 2; ++qi) { const float alpha = ex2(mrow[qi] - mnew[qi]); mrow[qi] = mnew[qi]; L[qi] = L[qi] * alpha;
#pragma unroll
            for (int dt = 0; dt < 4; ++dt) O[dt][qi] = O[dt][qi] * alpha; }
    }
#pragma unroll
    for (int qi = 0; qi < 2; ++qi) { const int qtg = 2 * QH + qi; const float mref = mrow[qi];
#pragma unroll
        for (int kt = 0; kt < 4; ++kt) if (USED(kt, qtg)) {
#pragma unroll
            for (int j = 0; j < 4; ++j) S[kt][qi][j] = LOCAL ? ex2(S[kt][qi][j] - mref) : ex2(__builtin_fmaf(S[kt][qi][j], C1, -mref)); }
#pragma unroll
        for (int kp = 0; kp < 2; ++kp) { u32x4 w = (u32x4){0u, 0u, 0u, 0u};
            if (USED(2 * kp, qtg)) { w.x = cvt_pk_bf16(S[2 * kp][qi][0], S[2 * kp][qi][1]); w.y = cvt_pk_bf16(S[2 * kp][qi][2], S[2 * kp][qi][3]); }
            if (USED(2 * kp + 1, qtg)) { w.z = cvt_pk_bf16(S[2 * kp + 1][qi][0], S[2 * kp + 1][qi][1]); w.w = cvt_pk_bf16(S[2 * kp + 1][qi][2], S[2 * kp + 1][qi][3]); }
            pb[qi][kp] = __builtin_bit_cast(bf16x8, w); }
    }
}
template <bool LOCAL, int QH>
__device__ __forceinline__ void attn_pv(f32x4 (&O)[4][2], f32x4 (&L)[2], const bf16x8 (&pb)[2][2], const s16x4 (&va)[2][4], const s16x4 (&vb)[2][4]) {
    __builtin_amdgcn_s_setprio(1);
    const bf16x8 ones = (bf16x8){(short)0x3F80, (short)0x3F80, (short)0x3F80, (short)0x3F80, (short)0x3F80, (short)0x3F80, (short)0x3F80, (short)0x3F80};
#pragma unroll
    for (int kp = 0; kp < 2; ++kp) {
#pragma unroll
        for (int qi = 0; qi < 2; ++qi) if (!LOCAL || (kp == 0 ? (2 * QH + qi) <= 2 : (2 * QH + qi) >= 1)) L[qi] = MFMA16(ones, pb[qi][kp], L[qi]);
    }
#pragma unroll
    for (int kp = 0; kp < 2; ++kp)
#pragma unroll
        for (int dt = 0; dt < 4; ++dt) { const s16x4 a = va[kp][dt], b = vb[kp][dt];
            const bf16x8 vf = (bf16x8){a[0], a[1], a[2], a[3], b[0], b[1], b[2], b[3]};
#pragma unroll
            for (int qi = 0; qi < 2; ++qi) if (!LOCAL || (kp == 0 ? (2 * QH + qi) <= 2 : (2 * QH + qi) >= 1)) O[dt][qi] = MFMA16(vf, pb[qi][kp], O[dt][qi]); }
    __builtin_amdgcn_s_setprio(0);
}
template <int QH>
__device__ __forceinline__ void attn_half(int u, int layer, const unsigned char* ws, const LAS float* rpbs, int lane) {
    const int g = lane >> 4, c16 = lane & 15, h = u & 7;
    const bf16 *Q = (const bf16*)(ws + WS_Q), *K = (const bf16*)(ws + WS_K), *VT = (const bf16*)(ws + WS_VT), *CK = (const bf16*)(ws + WS_CK), *CVT = (const bf16*)(ws + WS_CVT);
    bf16* MIX = (bf16*)(ws + WS_MIX);
    const bool lat = u < 4096; int b, r = 0, qrow0;
    if (lat) { b = u >> 9; r = (u >> 3) & 63; qrow0 = NCTX + b * 4096 + r * 64; } else { const int uc = u - 4096; b = uc >> 5; qrow0 = b * 256 + ((uc >> 3) & 3) * 64; }
    qrow0 += 32 * QH;
    bf16x8 qf[2][2];
#pragma unroll
    for (int qi = 0; qi < 2; ++qi) { const bf16* qp = Q + (size_t)(qrow0 + 16 * qi + c16) * 512 + h * 64 + 8 * g; qf[qi][0] = *(const bf16x8*)qp; qf[qi][1] = *(const bf16x8*)(qp + 32); }
    f32x4 O[4][2], L[2]; float mrow[2]; int lo[2];
#pragma unroll
    for (int qi = 0; qi < 2; ++qi) { mrow[qi] = -1e30f; L[qi] = (f32x4){0.f, 0.f, 0.f, 0.f}; int cs = 32 * QH + 16 * qi + c16 - 8; cs = cs < 0 ? 0 : (cs > 48 ? 48 : cs); lo[qi] = cs - 4 * g;
#pragma unroll
        for (int dt = 0; dt < 4; ++dt) O[dt][qi] = (f32x4){0.f, 0.f, 0.f, 0.f}; }
    int rs = r - 4; rs = rs < 0 ? 0 : (rs > 56 ? 56 : rs);
    const int nloc = lat ? 8 : 0, ntot = lat ? 12 : 4;
    const bf16* Kloc = K + (size_t)((64 + b * 64 + rs) * 8 + h) * 4096; const bf16* Vloc = VT + (size_t)((64 + b * 64 + rs) * 8 + h) * 4096;
    const size_t dch = lat ? (size_t)((b * 4 + layer) * 4 * 8 + h) * 4096 : (size_t)(b * 4 * 8 + h) * 4096;
    const bf16* Kden = (lat ? CK : K) + dch; const bf16* Vden = (lat ? CVT : VT) + dch;
#define KPTR(i) ((i) < nloc ? Kloc + (size_t)(i) * 32768 : Kden + (size_t)((i) - nloc) * 32768)
#define VPTR(i) ((i) < nloc ? Vloc + (size_t)(i) * 32768 : Vden + (size_t)((i) - nloc) * 32768)
#define VSTR(i) 64
    bf16x8 kf[4][2]; s16x4 va[2][4], vb[2][4]; f32x4 S[4][2]; bf16x8 pb[2][2];
    attn_load_k(KPTR(0), kf, g, c16); PIN_MEM();
    const LAS float* rl = rpbs + (4 * g - c16 + 31) + (rs - r + 7) * 64;
#pragma unroll 1
    for (int i = 0; i < nloc; ++i) {
        attn_load_v(VPTR(i), VSTR(i), va, vb, g, c16); PIN_MEM();
        attn_qk<true, QH>(S, kf, qf); PIN_MEM(); attn_load_k(KPTR(i + 1), kf, g, c16); PIN_MEM();
        attn_softmax<true, QH>(S, O, mrow, L, rl + i * 64, lo, pb);
        attn_pv<true, QH>(O, L, pb, va, vb); PIN_MEM();
    }
#pragma unroll 1
    for (int i = nloc; i < ntot; ++i) { const int in_ = i + 1 < ntot ? i + 1 : i;
        attn_load_v(VPTR(i), VSTR(i), va, vb, g, c16); PIN_MEM();
        attn_qk<false, QH>(S, kf, qf); PIN_MEM(); attn_load_k(KPTR(in_), kf, g, c16); PIN_MEM();
        attn_softmax<false, QH>(S, O, mrow, L, rl, lo, pb);
        attn_pv<false, QH>(O, L, pb, va, vb); PIN_MEM();
    }
#undef KPTR
#undef VPTR
#undef VSTR
#pragma unroll
    for (int qi = 0; qi < 2; ++qi) { const float il = 1.0f / L[qi][0];
        bf16* op = MIX + (size_t)(qrow0 + 16 * qi + c16) * DM + h * 64 + 4 * g;
#pragma unroll
        for (int dt = 0; dt < 4; ++dt) { const f32x4 o = O[dt][qi] * il; u32x2 pk; pk.x = cvt_pk_bf16(o[0], o[1]); pk.y = cvt_pk_bf16(o[2], o[3]); *(u32x2*)(op + 16 * dt) = pk; } }
}
template <int QH>
__device__ __forceinline__ void attn_local_band(const LAS unsigned char* bufk, const LAS unsigned char* bufv, const bf16x8 (&qf)[2][2], f32x4 (&O)[4][2], float (&mrow)[2], f32x4 (&L)[2],
                                                const LAS float* rp, const int (&lo)[2], int g, int c16) {
    constexpr float C1 = 0.125f * LOG2E;
    f32x4 S[2][2]; float mnew[2]; bool grow = false;
#pragma unroll
    for (int qi = 0; qi < 2; ++qi) { const int qtg = 2 * QH + qi; const int st = qtg == 0 ? 0 : (qtg == 1 ? 8 : (qtg == 2 ? 24 : 32));
        float mx = -1e30f;
#pragma unroll
        for (int t = 0; t < 2; ++t) { const int row = st + 16 * t + c16;
            const bf16x8 k0 = *(const LAS bf16x8*)(bufk + row * 128 + ((g ^ (row & 7)) << 4)), k1 = *(const LAS bf16x8*)(bufk + row * 128 + (((4 + g) ^ (row & 7)) << 4));
            f32x4 a = (f32x4){0.f, 0.f, 0.f, 0.f}; a = MFMA16(k0, qf[qi][0], a); a = MFMA16(k1, qf[qi][1], a);
#pragma unroll
            for (int j = 0; j < 4; ++j) { float v = __builtin_fmaf(a[j], C1, rp[st - 16 * qtg + 16 * t + j]); v = ((unsigned)(st + 16 * t + j - lo[qi]) < 16u) ? v : -1e30f; a[j] = v; mx = fmaxf(mx, v); }
            S[qi][t] = a; }
        mx = fmaxf(mx, __shfl_xor(mx, 16)); mx = fmaxf(mx, __shfl_xor(mx, 32));
        const bool gq = mx > mrow[qi] + 8.0f; mnew[qi] = gq ? mx : mrow[qi]; grow = grow || gq;
    }
    if (__any(grow)) {
#pragma unroll
        for (int qi = 0; qi < 2; ++qi) { const float alpha = ex2(mrow[qi] - mnew[qi]); mrow[qi] = mnew[qi]; L[qi] = L[qi] * alpha;
#pragma unroll
            for (int dt = 0; dt < 4; ++dt) O[dt][qi] = O[dt][qi] * alpha; }
    }
    const bf16x8 ones = (bf16x8){(short)0x3F80, (short)0x3F80, (short)0x3F80, (short)0x3F80, (short)0x3F80, (short)0x3F80, (short)0x3F80, (short)0x3F80};
#pragma unroll
    for (int qi = 0; qi < 2; ++qi) { const int qtg = 2 * QH + qi; const int st = qtg == 0 ? 0 : (qtg == 1 ? 8 : (qtg == 2 ? 24 : 32)); const float mref = mrow[qi];
        u32x4 w;
        { const f32x4 a = S[qi][0], b = S[qi][1];
          w.x = cvt_pk_bf16(ex2(a[0] - mref), ex2(a[1] - mref)); w.y = cvt_pk_bf16(ex2(a[2] - mref), ex2(a[3] - mref));
          w.z = cvt_pk_bf16(ex2(b[0] - mref), ex2(b[1] - mref)); w.w = cvt_pk_bf16(ex2(b[2] - mref), ex2(b[3] - mref)); }
        const bf16x8 pb = __builtin_bit_cast(bf16x8, w);
        L[qi] = MFMA16(ones, pb, L[qi]);
#pragma unroll
        for (int dt = 0; dt < 4; ++dt) { const int row = 16 * dt + c16, ch = (st >> 3) + (g >> 1);
            const s16x4 va = *(const LAS s16x4*)(bufv + row * 128 + ((ch ^ (row & 7)) << 4) + (g & 1) * 8), vb = *(const LAS s16x4*)(bufv + row * 128 + (((ch + 2) ^ (row & 7)) << 4) + (g & 1) * 8);
            const bf16x8 vf = (bf16x8){va[0], va[1], va[2], va[3], vb[0], vb[1], vb[2], vb[3]};
            O[dt][qi] = MFMA16(vf, pb, O[dt][qi]); }
    }
}
template <int QH>
__device__ __forceinline__ void attn_wg_half(bool lat, int b, int h, int r0, int layer, const unsigned char* ws, const LAS float* rpbs, LAS unsigned char* stg, int tid, int wave, int lane) {
    const int g = lane >> 4, c16 = lane & 15, qsub = wave >> 1;
    const bf16 *Q = (const bf16*)(ws + WS_Q), *K = (const bf16*)(ws + WS_K), *VT = (const bf16*)(ws + WS_VT), *CK = (const bf16*)(ws + WS_CK), *CVT = (const bf16*)(ws + WS_CVT);
    bf16* MIX = (bf16*)(ws + WS_MIX);
    const int r = r0 + qsub; const int qrow0 = (lat ? NCTX + b * 4096 + r * 64 : b * 256 + qsub * 64) + 32 * QH;
    bf16x8 qf[2][2];
#pragma unroll
    for (int qi = 0; qi < 2; ++qi) { const bf16* qp = Q + (size_t)(qrow0 + 16 * qi + c16) * 512 + h * 64 + 8 * g; qf[qi][0] = *(const bf16x8*)qp; qf[qi][1] = *(const bf16x8*)(qp + 32); }
    f32x4 O[4][2], L[2]; float mrow[2]; int lo[2];
#pragma unroll
    for (int qi = 0; qi < 2; ++qi) { mrow[qi] = -1e30f; L[qi] = (f32x4){0.f, 0.f, 0.f, 0.f}; int cs = 32 * QH + 16 * qi + c16 - 8; cs = cs < 0 ? 0 : (cs > 48 ? 48 : cs); lo[qi] = cs - 4 * g;
#pragma unroll
        for (int dt = 0; dt < 4; ++dt) O[dt][qi] = (f32x4){0.f, 0.f, 0.f, 0.f}; }
    int rs = r - 4; rs = rs < 0 ? 0 : (rs > 56 ? 56 : rs);
    int U0 = r0 - 4; U0 = U0 < 0 ? 0 : (U0 > 56 ? 56 : U0); int U1 = r0 - 1; U1 = (U1 < 0 ? 0 : (U1 > 56 ? 56 : U1)) + 7;
    const int nU = lat ? U1 - U0 + 1 : 0, ntot = nU + 4;
    const size_t loc0 = (size_t)((64 + b * 64 + U0) * 8 + h) * 4096, den0 = lat ? (size_t)((b * 4 + layer) * 4 * 8 + h) * 4096 : (size_t)(b * 4 * 8 + h) * 4096;
    const bf16 *Kd = lat ? CK : K, *Vd = lat ? CVT : VT;
#define TILE_K(s_) ((s_) < nU ? K + loc0 + (size_t)(s_) * 32768 : Kd + den0 + (size_t)((s_) - nU) * 32768)
#define TILE_V(s_) ((s_) < nU ? VT + loc0 + (size_t)(s_) * 32768 : Vd + den0 + (size_t)((s_) - nU) * 32768)
    const int srow = tid >> 3, wpos = srow * 128 + (((tid & 7) ^ (srow & 7)) << 4);
    const LAS float* rl = rpbs + (4 * g - c16 + 31);
    u32x4 kreg = *(const u32x4*)(TILE_K(0) + tid * 8), vreg = *(const u32x4*)(TILE_V(0) + tid * 8);
    *(LAS u32x4*)(stg + wpos) = kreg; *(LAS u32x4*)(stg + 8192 + wpos) = vreg;
    kreg = *(const u32x4*)(TILE_K(1) + tid * 8); vreg = *(const u32x4*)(TILE_V(1) + tid * 8);
    u32x4 kreg2 = kreg, vreg2 = vreg;
    __syncthreads();
#pragma unroll 1
    for (int s_ = 0; s_ < ntot; ++s_) {
        const bool more = s_ + 1 < ntot;
        if (s_ + 2 < ntot) { kreg2 = *(const u32x4*)(TILE_K(s_ + 2) + tid * 8); vreg2 = *(const u32x4*)(TILE_V(s_ + 2) + tid * 8); }
        PIN_MEM();
        const LAS unsigned char* bufk = stg + (s_ & 1) * 16384; const LAS unsigned char* bufv = bufk + 8192;
        const int kro = U0 + s_; const bool local = s_ < nU;
        if (local) { if (kro >= rs && kro <= rs + 7) attn_local_band<QH>(bufk, bufv, qf, O, mrow, L, rl + (kro - r + 7) * 64, lo, g, c16); }
        else {
            f32x4 S[4][2]; bf16x8 pb[2][2];
            { bf16x8 kf[4][2];
#pragma unroll
              for (int kt = 0; kt < 4; ++kt) { const int row = 16 * kt + c16;
#pragma unroll
                for (int ks = 0; ks < 2; ++ks) kf[kt][ks] = *(const LAS bf16x8*)(bufk + row * 128 + (((ks * 4 + g) ^ (row & 7)) << 4)); }
              attn_qk<false, QH>(S, kf, qf); }
            PIN_MEM();
            attn_softmax<false, QH>(S, O, mrow, L, rl, lo, pb);
            PIN_MEM();
            { s16x4 va[2][4], vb[2][4];
#pragma unroll
              for (int kp = 0; kp < 2; ++kp)
#pragma unroll
                for (int dt = 0; dt < 4; ++dt) { const int row = 16 * dt + c16, ch = kp * 4 + (g >> 1);
                    va[kp][dt] = *(const LAS s16x4*)(bufv + row * 128 + ((ch ^ (row & 7)) << 4) + (g & 1) * 8);
                    vb[kp][dt] = *(const LAS s16x4*)(bufv + row * 128 + (((ch + 2) ^ (row & 7)) << 4) + (g & 1) * 8); }
              attn_pv<false, QH>(O, L, pb, va, vb); }
        }
        if (more) { LAS unsigned char* nb = stg + ((s_ + 1) & 1) * 16384; *(LAS u32x4*)(nb + wpos) = kreg; *(LAS u32x4*)(nb + 8192 + wpos) = vreg; }
        kreg = kreg2; vreg = vreg2;
        __syncthreads();
    }
#undef TILE_K
#undef TILE_V
#pragma unroll
    for (int qi = 0; qi < 2; ++qi) { const float il = 1.0f / L[qi][0];
        bf16* op = MIX + (size_t)(qrow0 + 16 * qi + c16) * DM + h * 64 + 4 * g;
#pragma unroll
        for (int dt = 0; dt < 4; ++dt) { const f32x4 o = O[dt][qi] * il; u32x2 pk; pk.x = cvt_pk_bf16(o[0], o[1]); pk.y = cvt_pk_bf16(o[2], o[3]); *(u32x2*)(op + 16 * dt) = pk; } }
}
__device__ __forceinline__ void attn_unit(int u, int layer, const unsigned char* ws, const LAS float* rpbs, int lane) {
    attn_half<0>(u, layer, ws, rpbs, lane); attn_half<1>(u, layer, ws, rpbs, lane);
}
template <bool APPLY, bool SPLIT = true>
__device__ __forceinline__ void lru_unit(int u, int layer, const Params& P, LAS unsigned char* xsb, LAS unsigned char* xcb, LAS bf16* tsc, int lane) {
    const unsigned char* ws = P.ws;
    constexpr int LSTR = 72;
    const int g = lane >> 4, c16 = lane & 15, hf = SPLIT ? (u & 1) : 0, n = SPLIT ? ((u >> 1) & 7) : (u & 7), cgi = SPLIT ? (u >> 4) : (u >> 3);
    const bool ctx = cgi < 64; const int b = ctx ? cgi >> 2 : (cgi - 64) >> 6, ci = ctx ? cgi & 3 : (cgi - 64) & 63, nc = ctx ? 4 : 64, cg0 = cgi - ci;
    const int row0 = cgi * 64;
    const bf16 *XB = (const bf16*)(ws + WS_XB), *YB = (const bf16*)(ws + WS_YB), *WL = (const bf16*)(ws + WS_LRUW);
    LAS bf16* xs = (LAS bf16*)xsb; LAS bf16* xct = SPLIT ? (LAS bf16*)xcb : xs; const int sub = SPLIT ? hf : 0;
    LDS_FENCE();
#pragma unroll
    for (int i = 0; i < 9; ++i) { const int rr = i * 8 + (lane >> 3); if (rr < 67 && (!SPLIT || ((rr < 34) == (sub == 0)))) { const bool ok = !((ci == 0 && rr < 2) || (ci == nc - 1 && rr == 66));
            u32x4 v = (u32x4){0u, 0u, 0u, 0u}; if (ok) v = *(const u32x4*)(XB + (size_t)(row0 - 2 + rr) * 512 + n * 64 + (lane & 7) * 8);
            *(LAS u32x4*)(xs + rr * LSTR + (lane & 7) * 8) = v; } }
    LDS_FENCE();
    if (SPLIT) __syncthreads();
    {
        u32x4 xcf[4][2];
        const float* cw = P.in[14] + (size_t)layer * 4 * 512 + n * 64; const float* cb = P.in[15] + layer * 512 + n * 64;
#pragma unroll
        for (int ks = 0; ks < 2; ++ks) { const int ch = 32 * ks + 8 * g; float w[4][8], bb[8];
#pragma unroll
            for (int e = 0; e < 8; ++e) { bb[e] = cb[ch + e];
#pragma unroll
                for (int t = 0; t < 4; ++t) w[t][e] = cw[t * 512 + ch + e]; }
#pragma unroll
            for (int mq = 0; mq < (SPLIT ? 2 : 4); ++mq) { const int mt = SPLIT ? 2 * sub + mq : mq; float x[8];
#pragma unroll
                for (int e = 0; e < 8; ++e) x[e] = bb[e];
#pragma unroll
                for (int t = 0; t < 4; ++t) { const bf16x8 xv = *(const LAS bf16x8*)(xs + (16 * mt + c16 + t) * LSTR + ch);
#pragma unroll
                    for (int e = 0; e < 8; ++e) x[e] += w[t][e] * __uint_as_float((unsigned)(unsigned short)xv[e] << 16); }
                xcf[mq][ks].x = cvt_pk_bf16(x[0], x[1]); xcf[mq][ks].y = cvt_pk_bf16(x[2], x[3]); xcf[mq][ks].z = cvt_pk_bf16(x[4], x[5]); xcf[mq][ks].w = cvt_pk_bf16(x[6], x[7]); } }
        LDS_FENCE();
#pragma unroll
        for (int mq = 0; mq < (SPLIT ? 2 : 4); ++mq) { const int mt = SPLIT ? 2 * sub + mq : mq;
#pragma unroll
            for (int ks = 0; ks < 2; ++ks) *(LAS u32x4*)(xct + (16 * mt + c16) * LSTR + 32 * ks + 8 * g) = xcf[mq][ks]; }
        LDS_FENCE();
    }
    if (SPLIT) __syncthreads();
#define AFRAG(mt, ks) (*(const LAS bf16x8*)(xct + (16 * (c16 >> 2) + 4 * (mt) + (c16 & 3)) * LSTR + 32 * (ks) + 8 * g))
#pragma unroll
    for (int nq = 0; nq < (SPLIT ? 2 : 4); ++nq) { const int nt = 2 * hf + nq;
        float hs[4][4];
        const int ch = n * 64 + 16 * nt + c16;
        u32x4 yreg0 = (u32x4){0u, 0u, 0u, 0u}, yreg1 = yreg0;
        if (APPLY) { const bf16* yp = YB + ((size_t)row0 + lane) * 512 + n * 64 + 16 * nt; yreg0 = *(const u32x4*)yp; yreg1 = *(const u32x4*)(yp + 8); }
        float Hc[2] = {0.f, 0.f};
        if (APPLY) { Hc[0] = ((const float*)(ws + WS_CARRY))[(size_t)cgi * 512 + ch]; Hc[1] = ((const float*)(ws + WS_CARRY))[((size_t)576 + cgi) * 512 + ch]; }
#pragma unroll
        for (int dir = 0; dir < 2; ++dir) {
            const bf16* wr_ = WL + (size_t)(((layer * 2 + dir) * 2 + 0) * 8 + n) * 4096; const bf16* wi_ = wr_ + 8 * 4096;
            float2* AGG = (float2*)(ws + WS_AGG) + (size_t)dir * 576 * 512;
            const float br = P.in[18][(layer * 2 + dir) * 512 + ch], bi = P.in[20][(layer * 2 + dir) * 512 + ch], lam = P.in[16][(layer * 2 + dir) * 512 + ch];
            const float c8 = -8.0f * LOG2E * log1pf(expf(-lam));
            bf16x8 wrf[2], wif[2], idf;
#pragma unroll
            for (int ks = 0; ks < 2; ++ks) { wrf[ks] = *(const bf16x8*)(wr_ + (16 * nt + c16) * 64 + 32 * ks + 8 * g); wif[ks] = *(const bf16x8*)(wi_ + (16 * nt + c16) * 64 + 32 * ks + 8 * g); }
            { const int e = 16 * (nq & 1) + c16 - 8 * g;
#pragma unroll
              for (int q = 0; q < 8; ++q) idf[q] = (q == e) ? (short)0x3F80 : (short)0; }
            float av[4][4], bv[4][4];
#pragma unroll
            for (int mt = 0; mt < 4; ++mt) {
                f32x4 zr = (f32x4){0.f, 0.f, 0.f, 0.f}, zi = zr, xc = zr;
                const bf16x8 af0 = AFRAG(mt, 0), af1 = AFRAG(mt, 1);
                __builtin_amdgcn_s_setprio(1);
                zr = MFMA16(af0, wrf[0], zr); zr = MFMA16(af1, wrf[1], zr);
                zi = MFMA16(af0, wif[0], zi); zi = MFMA16(af1, wif[1], zi);
                xc = MFMA16((SPLIT ? hf : (nq >> 1)) ? af1 : af0, idf, xc); __builtin_amdgcn_s_setprio(0);
#pragma unroll
                for (int j = 0; j < 4; ++j) { const float rg = sigm(zr[j] + br), ig = sigm(zi[j] + bi); const float a = ex2(c8 * rg);
                    av[mt][j] = a; bv[mt][j] = sqrtf(fmaxf(1.0f - a * a, 0.f)) * ig * xc[j]; }
            }
            float H = APPLY ? Hc[dir] : 0.f;
            float Aloc = 1.f, Bloc = 0.f;
#pragma unroll
            for (int q = 0; q < 16; ++q) { const int s_ = dir == 0 ? q : 15 - q; const float a_ = av[s_ >> 2][s_ & 3], b_ = bv[s_ >> 2][s_ & 3]; Bloc = a_ * Bloc + b_; Aloc *= a_; }
            float Hin = H;
#pragma unroll
            for (int q = 0; q < 3; ++q) { const int gp = dir == 0 ? q : 3 - q; const float Ag = __shfl(Aloc, c16 + 16 * gp), Bg = __shfl(Bloc, c16 + 16 * gp); const float Hn = Ag * Hin + Bg;
                Hin = (dir == 0 ? g > gp : g < gp) ? Hn : Hin; }
            if (APPLY) { float h = Hin;
#pragma unroll
                for (int q = 0; q < 16; ++q) { const int s_ = dir == 0 ? q : 15 - q; h = av[s_ >> 2][s_ & 3] * h + bv[s_ >> 2][s_ & 3];
                    if (dir == 0) hs[s_ >> 2][s_ & 3] = h; else hs[s_ >> 2][s_ & 3] += h; } }
            H = __shfl(Aloc * Hin + Bloc, dir == 0 ? 48 + c16 : c16);
            float Aall = Aloc;
            if (!APPLY) { Aall *= __shfl_xor(Aall, 16); Aall *= __shfl_xor(Aall, 32); if (g == 0) AGG[(size_t)cgi * 512 + ch] = make_float2(Aall, H); }
            else if (ctx && g == 0 && ((dir == 0 && ci == nc - 1) || (dir == 1 && ci == 0))) P.out[OUT_ST + ((size_t)(b * 4 + layer) * 2 + dir) * 512 + ch] = H;
            PIN_MEM();
        }
        if (APPLY) {
            bf16* MIX = (bf16*)(ws + WS_MIX);
            LDS_FENCE();
            *(LAS u32x4*)(tsc + lane * 16) = yreg0; *(LAS u32x4*)(tsc + lane * 16 + 8) = yreg1;
            LDS_FENCE();
#pragma unroll
            for (int mt = 0; mt < 4; ++mt)
#pragma unroll
                for (int j = 0; j < 4; ++j) { LAS bf16* pe = tsc + (16 * g + 4 * mt + j) * 16 + c16;
                    const float y = __uint_as_float((unsigned)*pe << 16);
                    const float ge = y * sigm(1.5957691216057308f * (y + 0.044715f * y * y * y));
                    *pe = (bf16)(cvt_pk_bf16(hs[mt][j] * ge, 0.f) & 0xffffu); }
            LDS_FENCE();
            const u32x4 o0 = *(const LAS u32x4*)(tsc + lane * 16), o1 = *(const LAS u32x4*)(tsc + lane * 16 + 8);
            bf16* op = MIX + ((size_t)row0 + lane) * DM + 512 + n * 64 + 16 * nt; *(u32x4*)op = o0; *(u32x4*)(op + 8) = o1;
        }
        PIN_MEM();
    }
#undef AFRAG
}

__device__ __forceinline__ void carry_phase(int layer, const Params& P, unsigned char* ws, int gt, int ngt) {
    const float2* AGG = (const float2*)(ws + WS_AGG); float* CARRY = (float*)(ws + WS_CARRY);
    for (int it = gt; it < 24 * 2 * 512; it += ngt) {
        const int ch = it & 511, dir = (it >> 9) & 1, sq = it >> 10;
        const bool ctx = sq < 16; const int nc = ctx ? 4 : 64, cg0 = ctx ? sq * 4 : 64 + (sq - 16) * 64;
        float H = ctx ? 0.f : P.in[4][((size_t)((sq - 16) * 4 + layer) * 2 + dir) * 512 + ch];
        const float2* ag = AGG + ((size_t)dir * 576 + cg0) * 512 + ch; float* cr = CARRY + ((size_t)dir * 576 + cg0) * 512 + ch;
        if (ctx) { float2 ab[4];
#pragma unroll
            for (int k = 0; k < 4; ++k) { const int c = dir == 0 ? k : 3 - k; ab[k] = ag[(size_t)c * 512]; }
#pragma unroll
            for (int k = 0; k < 4; ++k) { const int c = dir == 0 ? k : 3 - k; cr[(size_t)c * 512] = H; H = ab[k].x * H + ab[k].y; }
        } else {
#pragma unroll 1
            for (int c0 = 0; c0 < 64; c0 += 16) { float2 ab[16];
#pragma unroll
                for (int k = 0; k < 16; ++k) { const int c = dir == 0 ? c0 + k : 63 - c0 - k; ab[k] = ag[(size_t)c * 512]; }
#pragma unroll
                for (int k = 0; k < 16; ++k) { const int c = dir == 0 ? c0 + k : 63 - c0 - k; cr[(size_t)c * 512] = H; H = ab[k].x * H + ab[k].y; } }
        }
    }
}

__device__ __forceinline__ void bias_layer(unsigned char* ws, int l, int lane, int widx, int nw) {
    const float* MODS = (const float*)(ws + WS_MODS); float* B1 = (float*)(ws + WS_BIAS1); float* B2 = (float*)(ws + WS_BIAS2);
    for (int rr = widx; rr < 8192; rr += nw) { const bool first = rr < 2560;
        const bf16* wrow = first ? (const bf16*)(ws + WS_WIN) + ((size_t)l * NIN + rr) * DM : (const bf16*)(ws + WS_WGU) + ((size_t)l * NGU + (rr - 2560)) * DM;
        const u32x4 wa = *(const u32x4*)(wrow + 16 * lane), wb = *(const u32x4*)(wrow + 16 * lane + 8); float wf[16];
#pragma unroll
        for (int e = 0; e < 4; ++e) { wf[2 * e] = __uint_as_float(wa[e] << 16); wf[2 * e + 1] = __uint_as_float(wa[e] & 0xffff0000u); wf[8 + 2 * e] = __uint_as_float(wb[e] << 16); wf[8 + 2 * e + 1] = __uint_as_float(wb[e] & 0xffff0000u); }
#pragma unroll 1
        for (int mg = 0; mg < 9; ++mg) { const float* sh = MODS + (size_t)(l * 9 + mg) * 6144 + (first ? 0 : 3072) + 16 * lane; float d = 0.f;
#pragma unroll
            for (int q = 0; q < 4; ++q) { const f32x4 sv = *(const f32x4*)(sh + 4 * q); d += (sv[0] * wf[4 * q] + sv[1] * wf[4 * q + 1]) + (sv[2] * wf[4 * q + 2] + sv[3] * wf[4 * q + 3]); }
            d = wave_sum(d);
            if (lane == 0) { if (first) B1[(size_t)(l * 9 + mg) * 2560 + rr] = d; else B2[(size_t)(l * 9 + mg) * 5632 + (rr - 2560)] = d; } }
    }
}
__device__ __forceinline__ void prep_phase(const Params& P, unsigned char* ws, int bid, int G, int tid, int wave, int lane) {
    const int gw = bid * 8 + wave, ngw = G * 8;
    const float* MODS = (const float*)(ws + WS_MODS); bf16* HN = (bf16*)(ws + WS_HN); float* PART = (float*)(ws + WS_PART);
    for (int row = gw; row < MTOK; row += ngw) {
        const float* xr = row < NCTX ? P.in[0] + (size_t)row * DM : P.in[1] + (size_t)(row - NCTX) * DM;
        const int mg = row < NCTX ? 0 : 1 + ((row - NCTX) >> 12); const float* mp = MODS + mg * 6144;
        float s = 0.f;
#pragma unroll
        for (int j = 0; j < 4; ++j) { const int c = 256 * j + 4 * lane; const f32x4 v = *(const f32x4*)(xr + c), w = *(const f32x4*)(P.in[9] + c), sc = *(const f32x4*)(mp + 1024 + c);
            s += (v[0] * v[0] + v[1] * v[1]) + (v[2] * v[2] + v[3] * v[3]);
            const f32x4 o = v * (w * (sc + 1.0f)); u32x2 pk; pk.x = cvt_pk_bf16(o[0], o[1]); pk.y = cvt_pk_bf16(o[2], o[3]); *(u32x2*)(HN + (size_t)row * DM + c) = pk; }
        s = wave_sum(s);
        if (lane < 4) PART[(size_t)row * 4 + lane] = lane == 0 ? s : 0.f;
    }
    {
        float* WP = (float*)(ws + WS_WP);
        for (int i = bid * 512 + tid; i < 4 * 2 * 9 * 1024; i += G * 512) { const int c = i & 1023, t = i >> 10, mg = t % 9, lw = t / 9, which = lw & 1, l = lw >> 1;
            WP[i] = P.in[which ? 10 : 9][l * 1024 + c] * (1.0f + MODS[(size_t)(l * 9 + mg) * 6144 + (which ? 4096 : 1024) + c]); }
    }
    bias_layer(ws, 0, lane, gw, ngw);
}

__global__ void __launch_bounds__(512, 2) hybrid_fwd(Params P) {
    extern __shared__ __attribute__((aligned(16))) unsigned char lds_raw[];
    LAS unsigned char* lds = (LAS unsigned char*)lds_raw;
    cg::grid_group grid = cg::this_grid();
    int ph = 0;
#ifndef REP
#define REP 0u
#endif
#define REPEAT(k) for (int rep_ = 0; rep_ < (int)((REP >> (k)) & 1u) + 1; ++rep_)
#define IDS int tid = threadIdx.x; asm volatile("" : "+v"(tid)); int bid = IDS_BID; asm volatile("" : "+s"(bid)); int G = gridDim.x; asm volatile("" : "+s"(G)); \
    const int lane = tid & 63, wave = __builtin_amdgcn_readfirstlane(tid >> 6), gw = bid * 8 + wave, ngw = G * 8; \
    size_t zoff = 0; asm volatile("" : "+s"(zoff)); unsigned char* ws = P.ws + zoff; float* XR = P.out + zoff; (void)lane; (void)gw; (void)ngw; (void)ws; (void)XR;
#define PHASE_BEGIN if (ph >= P.ph_lo && ph < P.ph_hi) {
#define PHASE_END   if (ph + 1 < P.ph_hi) { xcd_barrier(xbar); if ((REP >> 12) & 1u) xcd_barrier(xbar); } } ++ph;
    volatile LAS unsigned* bst = (volatile LAS unsigned*)(lds + LDS_BYTES - 64);
    if (threadIdx.x < 3) bst[threadIdx.x] = 0u;
    XcdBarrier xbar;
#define IDS_BID blockIdx.x
    { IDS if (ph >= P.ph_lo && ph < P.ph_hi) { if (bid == 0) for (int i = tid; i < XCD_BAR_WORDS; i += 512) ((unsigned*)ws)[i] = 0u;
        REPEAT(0) { prologue(P, lds, tid, wave, lane); __syncthreads(); }
        if (ph + 1 < P.ph_hi) grid.sync(); } ++ph;
      xbar = xcd_barrier_post((unsigned*)ws, bst); }
    { IDS PHASE_BEGIN prep_phase(P, ws, bid, G, tid, wave, lane); PHASE_END }
#undef IDS_BID
#define IDS_BID vbid
    int vbid = blockIdx.x;
    if (P.ph_hi > 2) { const unsigned* bw = (const unsigned*)P.ws; bool okc = (gridDim.x & 7) == 0;
        for (int j = 0; j < 16; ++j) { const unsigned c = xb_ld((unsigned*)bw + XB_XCNT(j)); okc = okc && (j < 8 ? c == gridDim.x / 8 : c == 0u); }
        __syncthreads();
        vbid = __builtin_amdgcn_readfirstlane(okc ? (int)(bst[2] * 8u + xbar.x) : (int)blockIdx.x); }
#pragma unroll 1
    for (int l = 0; l < DEPTH; ++l) {
        IDS
        bf16 *HN = (bf16*)(ws + WS_HN), *MIX = (bf16*)(ws + WS_MIX), *ACT = (bf16*)(ws + WS_ACT);
        const float* mods = (const float*)(ws + WS_MODS) + (size_t)l * 9 * 6144;
        const float* xlo = l == 0 ? P.in[0] : XR; const float* xhi = l == 0 ? P.in[1] : XR + (size_t)NCTX * DM;
        PHASE_BEGIN {
            pg8::Gemm gm{HN, (const bf16*)(ws + WS_WIN) + (size_t)l * NIN * DM, MTOK, NIN, DM}; pg8::RstdOrder S; S.init(MTOK, NIN, G, bid); S.PART = (const float*)(ws + WS_PART); S.sbuf = (LAS float*)(lds + 131072); S.cnt = 0; S.bias = (const float*)(ws + WS_BIAS1) + (size_t)l * 9 * 2560; S.bstride = 2560;
            pg8::EpiIn E{ws, XR, l, (LAS float*)(lds + 131072), 0};
            REPEAT(2) pg8::gemm_phase<pg8::EpiIn, pg8::RstdOrder, true, true>(lds, gm, S, E); } PHASE_END
        PHASE_BEGIN {
            LAS float* rpbs = (LAS float*)(lds + wave * 3840);
#define LOAD_RPB(hh) do { LDS_FENCE(); for (int i = lane; i < 15 * 64; i += 64) { const int ri = i >> 6, cpos = (i & 63) - 16; \
                rpbs[i] = (cpos >= 0 && cpos < 31) ? P.in[13][((size_t)(l * 8 + (hh)) * 15 + ri) * 31 + cpos] * LOG2E : 0.f; } LDS_FENCE(); } while (0)
            REPEAT(3) { if (G == 256) {
                    const int bx = bid & 7, bc = bid >> 3; LAS unsigned char* stg = lds + 32768;
                    for (int hp = 0; hp < 4; ++hp) { const int h = 2 * hp + (bc >> 4), r0 = 4 * (bc & 15); LOAD_RPB(h);
                        if (wave & 1) attn_wg_half<1>(true, bx, h, r0, l, ws, rpbs, stg, tid, wave, lane); else attn_wg_half<0>(true, bx, h, r0, l, ws, rpbs, stg, tid, wave, lane); }
                    if (bc < 16) { const int cb_ = 2 * bx + (bc >> 3), h = bc & 7;
                        if (wave & 1) attn_wg_half<1>(false, cb_, h, 0, l, ws, rpbs, stg, tid, wave, lane); else attn_wg_half<0>(false, cb_, h, 0, l, ws, rpbs, stg, tid, wave, lane); }
                    __syncthreads();
                } else { LOAD_RPB(wave); for (int u = gw; u < 4608; u += ngw) attn_unit(u, l, ws, rpbs, lane); } }
#undef LOAD_RPB
            REPEAT(4) for (int u = (ngw - 1 - gw); u < 9216; u += ngw) lru_unit<false>(u, l, P, lds + 32768 + (wave >> 1) * 9728, lds + 32768 + 4 * 9728 + (wave >> 1) * 9216, (LAS bf16*)(lds + wave * 3840), lane);
        } PHASE_END
        PHASE_BEGIN carry_phase(l, P, ws, bid * 512 + tid, G * 512); PHASE_END
        PHASE_BEGIN { REPEAT(5) for (int u = gw; u < 9216; u += ngw) lru_unit<true>(u, l, P, lds + 32768 + (wave >> 1) * 9728, lds + 32768 + 4 * 9728 + (wave >> 1) * 9216, (LAS bf16*)(lds + wave * 3840), lane); } PHASE_END
        PHASE_BEGIN {
            pg8::Gemm gm{MIX, (const bf16*)(ws + WS_WOUT) + (size_t)l * DM * DM, MTOK, DM, DM}; pg8::StaticOrder S; S.init(MTOK, DM, G, bid);
            pg8::EpiRes E{l == 0 ? P.in[0] : (const float*)nullptr, l == 0 ? P.in[1] : (const float*)nullptr, XR, l * 9 * 6144 + 2048, ws, l * 2 + 1, (LAS float*)(lds + 131072)};
            pg8::gemm_phase<pg8::EpiRes, pg8::StaticOrder, true, true>(lds, gm, S, E);
            if (l < DEPTH - 1) { const bool idle = (G == 256); if (!idle || bid >= 64) convert_layer(P, ws, l + 1, (LAS float*)(lds + wave * 8448), lane, idle ? (bid - 64) * 8 + wave : gw, idle ? 192 * 8 : ngw); } } PHASE_END
        PHASE_BEGIN {
            pg8::Gemm gm{HN, (const bf16*)(ws + WS_WGU) + (size_t)l * NGU * DM, MTOK, NGU, DM}; pg8::RstdOrder S; S.init(MTOK, NGU, G, bid); S.PART = (const float*)(ws + WS_PART); S.sbuf = (LAS float*)(lds + 131072); S.cnt = 0; S.bias = (const float*)(ws + WS_BIAS2) + (size_t)l * 9 * 5632; S.bstride = 5632;
            pg8::EpiGU E{ACT, (LAS float*)(lds + 131072), 0};
            REPEAT(8) pg8::gemm_phase<pg8::EpiGU, pg8::RstdOrder, true, true>(lds, gm, S, E); } PHASE_END
        PHASE_BEGIN {
            pg8::Gemm gm{ACT, (const bf16*)(ws + WS_WDN) + (size_t)l * DM * DFF, MTOK, DM, DFF}; pg8::StaticOrder S; S.init(MTOK, DM, G, bid);
            pg8::EpiRes E{(const float*)nullptr, (const float*)nullptr, XR, l * 9 * 6144 + 5120, ws, l < DEPTH - 1 ? (l + 1) * 2 : -1, (LAS float*)(lds + 131072)};
            pg8::gemm_phase<pg8::EpiRes, pg8::StaticOrder, true, true>(lds, gm, S, E);
            if (l < DEPTH - 1) { const bool idle = (G == 256); if (!idle || bid >= 64) bias_layer(ws, l + 1, lane, idle ? (bid - 64) * 8 + wave : gw, idle ? 192 * 8 : ngw); } } PHASE_END
    }
    { IDS PHASE_BEGIN final_norm_phase(XR, P.in[24], gw, ngw, lane); PHASE_END }
}

#ifndef N_LAUNCH_MODE
#define N_LAUNCH_MODE 1
#endif
extern "C" void kernel_launch(void* const* d_in, const int* in_sizes, int n_in, void* d_out, int out_size, void* d_ws, size_t ws_size, hipStream_t stream) {
    static int grid = 0;
    if (grid == 0) {
        int dev = 0, cus = 0, per_cu = 0;
        hipGetDevice(&dev); hipDeviceGetAttribute(&cus, hipDeviceAttributeMultiprocessorCount, dev);
        if (hipFuncSetAttribute((const void*)hybrid_fwd, hipFuncAttributeMaxDynamicSharedMemorySize, LDS_BYTES) != hipSuccess) fprintf(stderr, "kernel_launch: hipFuncSetAttribute failed\n");
        if (hipOccupancyMaxActiveBlocksPerMultiprocessor(&per_cu, (const void*)hybrid_fwd, 512, LDS_BYTES) != hipSuccess || per_cu < 1) { fprintf(stderr, "kernel_launch: occupancy query says %d\n", per_cu); per_cu = 1; }
        (void)hipGetLastError();
        grid = cus * 1;
        if (n_in != 25 || ws_size < 444 * MiB) fprintf(stderr, "kernel_launch: unexpected n_in %d / ws %zu\n", n_in, ws_size);
    }
    Params p{};
    for (int i = 0; i < 25; ++i) p.in[i] = (const float*)d_in[i];
    p.out = (float*)d_out; p.ws = (unsigned char*)d_ws;
#if N_LAUNCH_MODE == 1
    p.ph_lo = 0; p.ph_hi = 31;
    void* args[] = {&p};
    hipError_t e = hipLaunchCooperativeKernel((const void*)hybrid_fwd, dim3(grid), dim3(512), args, LDS_BYTES, stream);
    if (e != hipSuccess) fprintf(stderr, "cooperative launch failed: %s (grid %d)\n", hipGetErrorString(e), grid);
#else
    for (int ph = 0; ph < 31; ++ph) { p.ph_lo = ph; p.ph_hi = ph + 1; hipLaunchKernelGGL(hybrid_fwd, dim3(grid), dim3(512), LDS_BYTES, stream, p); }
#endif
}
```

```cpp
#include <hip/hip_runtime.h>
#include <hip/hip_cooperative_groups.h>
#include <cstdio>
#include <cstdint>
namespace cg = cooperative_groups;

constexpr int DM = 1024, NCTX = 4096, NLAT = 32768, MTOK = 36864, DEPTH = 4, NIN = 2560, DFF = 2816, NGU = 5632;
constexpr int OUT_K = MTOK * DM, OUT_V = OUT_K + 16 * 4 * 256 * 512, OUT_ST = OUT_V + 16 * 4 * 256 * 512;
constexpr size_t MiB = 1u << 20;
constexpr size_t WS_MODS = 1 * MiB, WS_LRUW = 2 * MiB, WS_AGG = 3 * MiB, WS_CK = 8 * MiB, WS_CVT = 16 * MiB, WS_WIN = 24 * MiB, WS_WOUT = 44 * MiB,
                 WS_WGU = 52 * MiB, WS_WDN = 96 * MiB, WS_HN = 120 * MiB, WS_Q = 192 * MiB, WS_K = 228 * MiB, WS_VT = 264 * MiB, WS_XB = 300 * MiB,
                 WS_YB = 336 * MiB, WS_MIX = 372 * MiB, WS_ACT = 192 * MiB, WS_CARRY = 444 * MiB, WS_PART = 448 * MiB, WS_BIAS1 = 452 * MiB, WS_BIAS2 = 453 * MiB, WS_WP = 455 * MiB;
namespace pg8 {
#define PG8_LAS __attribute__((address_space(3)))
typedef unsigned short bf16_t;
typedef short bf16x8 __attribute__((ext_vector_type(8)));
typedef float f32x4 __attribute__((ext_vector_type(4)));
typedef unsigned u32x4 __attribute__((ext_vector_type(4)));
constexpr int BM = 256, BK = 64, HALF = 128, HTB = HALF * BK * 2  , STAGE_BYTES = 8 * HTB, NXCD = 8, WGM = 4;

__host__ __device__ __forceinline__ int lds_byte(int r, int c) { const int st = (r >> 4) * 2 + (c >> 5), rr = r & 15, cc = c & 31, ob = rr * 64 + cc * 2; return st * 1024 + (ob ^ (((ob >> 9) & 1) << 5)); }
__host__ __device__ __forceinline__ void stage_rc(int b, int& R, int& C) { const int st = b / 1024, sb = b % 1024, swz = sb ^ (((sb >> 9) & 1) << 5); R = (st >> 1) * 16 + swz / 64; C = (st & 1) * 32 + (swz % 64) / 2; }
__host__ __device__ __forceinline__ int perm32(int rho) { const int n = rho >> 4, i = rho & 15; return 8 * (i >> 2) + 4 * n + (i & 3); }

struct Unit { int pm, pn; };
struct Gemm { const bf16_t* A; const bf16_t* Bt; int M, N, K; };

struct StaticOrder {
    int nM, nN, nwg, G, c;
    __host__ __device__ void init(int M, int N, int G_, int c_) { nM = M / BM; nN = N / BM; nwg = nM * nN; G = G_; c = c_; }
    __host__ __device__ bool next(int i, Unit& u) const {
        const long L = (long)i * G + c; if (L >= nwg) return false;
        int wgid = (int)L; { const int q = nwg / NXCD, r = nwg % NXCD, xcd = wgid % NXCD, off = wgid / NXCD; wgid = (xcd < r ? xcd * (q + 1) : r * (q + 1) + (xcd - r) * q) + off; }
        const int nig = WGM * nN, gid = wgid / nig, fm = gid * WGM, gsz = (nM - fm) < WGM ? (nM - fm) : WGM;
        u.pm = fm + ((wgid % nig) % gsz); u.pn = (wgid % nig) / gsz; return true;
    }
    __device__ __forceinline__ f32x4 a_ready(const Unit&) const { return (f32x4){0.f, 0.f, 0.f, 0.f}; }
    __device__ __forceinline__ void a_finish(const f32x4&) const {}
    __device__ __forceinline__ void done(const Unit&) const {}
};

struct RstdOrder : StaticOrder {
    const float* PART; const float* bias; int bstride; PG8_LAS float* sbuf; mutable int cnt;
    __device__ __forceinline__ f32x4 a_ready(const Unit& u) const {
        int t = threadIdx.x; asm volatile("" : "+v"(t)); f32x4 pend = (f32x4){0.f, 0.f, 0.f, 0.f};
        if (t < 256) pend = *(const f32x4*)(PART + ((size_t)u.pm * 256 + t) * 4);
        else if (t < 320) pend = *(const f32x4*)(bias + (size_t)(u.pm < 16 ? 0 : 1 + ((u.pm - 16) >> 4)) * bstride + u.pn * 256 + 4 * (t - 256));
        asm volatile("" ::: "memory"); return pend;
    }
    __device__ __forceinline__ void a_finish(const f32x4& pend) const {
        int t = threadIdx.x; asm volatile("" : "+v"(t));
        if (t < 256) sbuf[(cnt & 1) * 256 + t] = 1.0f / sqrtf(((pend[0] + pend[1]) + (pend[2] + pend[3])) * (1.0f / 1024.0f) + 1e-6f);
        else if (t < 320) *(PG8_LAS f32x4*)(sbuf + 512 + (cnt & 1) * 256 + 4 * (t - 256)) = pend;
        ++cnt;
    }
};
typedef float f32x2_c __attribute__((ext_vector_type(2))); typedef __bf16 bf16x2_c __attribute__((ext_vector_type(2)));
__device__ __forceinline__ unsigned cvt_pk_bf16(float lo, float hi) { f32x2_c v = {lo, hi}; bf16x2_c b = __builtin_convertvector(v, bf16x2_c); return __builtin_bit_cast(unsigned, b); }
typedef float f32x2 __attribute__((ext_vector_type(2)));
__device__ __forceinline__ float sigm(float x) { return __builtin_amdgcn_rcpf(1.f + __builtin_amdgcn_exp2f(-1.4426950408889634f * x)); }
typedef unsigned u32x2 __attribute__((ext_vector_type(2)));
__device__ __forceinline__ void row_rstd(const PG8_LAS float* srstd, int par, int wr, int fr, float (&rstd)[2][4]) {
#pragma unroll
    for (int ai = 0; ai < 2; ++ai)
#pragma unroll
        for (int m = 0; m < 4; ++m) rstd[ai][m] = srstd[par * 256 + ai * 128 + wr * 64 + m * 16 + fr];
}
struct EpiIn {
    static constexpr bool PERM = true, AFTER_DRAIN = false;
    unsigned char* wsb; float* outb; int layer; PG8_LAS float* srstd; mutable int ecnt;
    __device__ __forceinline__ void operator()(const f32x4 (&acc)[2][2][4][2], const Unit& u, int wr, int wc, int fr, int fq) const {
        float rstd[2][4]; row_rstd(srstd, ecnt & 1, wr, fr, rstd);
        const PG8_LAS float* bp = srstd + 512 + (ecnt & 1) * 256 + wc * 32 + 8 * fq; ++ecnt;
#define NV0 (acc[ai][bj][m][0] * rstd[ai][m] + bia0)
#define NV1 (acc[ai][bj][m][1] * rstd[ai][m] + bia1)
        bf16_t *Q = (bf16_t*)(wsb + WS_Q), *K = (bf16_t*)(wsb + WS_K), *VT = (bf16_t*)(wsb + WS_VT), *XB = (bf16_t*)(wsb + WS_XB), *YB = (bf16_t*)(wsb + WS_YB); float *outk = outb + OUT_K, *outv = outb + OUT_V;
        const int sec = u.pn >> 1; const unsigned colb = (u.pn & 1) * 256 + wc * 32 + 8 * fq, rowt = wr * 64 + fr;
        const int pm = u.pm; const bool ctx = pm < 16;
        if (sec == 2) {
            bf16_t* vt = VT + (unsigned)(4 * pm + wr) * 32768u + (colb >> 6) * 4096u + (colb & 63) * 64u + fr;
            float* ov = outv + (unsigned)(pm * 4 + layer) * 256u * 512u + rowt * 512u + colb;
#pragma unroll
            for (int bj = 0; bj < 2; ++bj) { const f32x4 bia0 = *(const PG8_LAS f32x4*)(bp + bj * 128), bia1 = *(const PG8_LAS f32x4*)(bp + bj * 128 + 4);
#pragma unroll
              for (int ai = 0; ai < 2; ++ai)
#pragma unroll
                for (int m = 0; m < 4; ++m) {
                    { const f32x4 v0 = NV0, v1 = NV1;
                        const unsigned w0 = cvt_pk_bf16(v0[0], v0[1]), w1 = cvt_pk_bf16(v0[2], v0[3]), w2 = cvt_pk_bf16(v1[0], v1[1]), w3 = cvt_pk_bf16(v1[2], v1[3]);
                        bf16_t* p = vt + (unsigned)(2 * ai) * 32768u + (unsigned)(bj * 2) * 4096u + m * 16;
                        p[0] = (bf16_t)w0; p[64] = (bf16_t)(w0 >> 16); p[128] = (bf16_t)w1; p[192] = (bf16_t)(w1 >> 16);
                        p[256] = (bf16_t)w2; p[320] = (bf16_t)(w2 >> 16); p[384] = (bf16_t)w3; p[448] = (bf16_t)(w3 >> 16);
                        if (ctx) { float* o = ov + (unsigned)(ai * 128 + m * 16) * 512u + bj * 128; *(f32x4*)o = v0; *(f32x4*)(o + 4) = v1; } }
                    asm volatile("" ::: "memory"); } }
        } else {
            bf16_t* base = (sec == 0 ? Q : sec == 3 ? XB : YB) + ((unsigned)pm * 256u + rowt) * 512u + colb;
            unsigned rstride = 512u, aistride = 128u * 512u, bjstride = 128u;
            if (sec == 1) { base = K + (unsigned)(4 * pm + wr) * 32768u + (colb >> 6) * 4096u + fr * 64u + (colb & 63); rstride = 64u; aistride = 2u * 32768u; bjstride = 2u * 4096u; }
            float* ok = outk + (unsigned)(pm * 4 + layer) * 256u * 512u + rowt * 512u + colb;
            const bool wk = sec == 1 && ctx;
#pragma unroll
            for (int bj = 0; bj < 2; ++bj) { const f32x4 bia0 = *(const PG8_LAS f32x4*)(bp + bj * 128), bia1 = *(const PG8_LAS f32x4*)(bp + bj * 128 + 4);
#pragma unroll
              for (int ai = 0; ai < 2; ++ai)
#pragma unroll
                for (int m = 0; m < 4; ++m) {
                    { const f32x4 v0 = NV0, v1 = NV1;
                        u32x4 w; w.x = cvt_pk_bf16(v0[0], v0[1]); w.y = cvt_pk_bf16(v0[2], v0[3]); w.z = cvt_pk_bf16(v1[0], v1[1]); w.w = cvt_pk_bf16(v1[2], v1[3]);
                        *(u32x4*)(base + ai * aistride + (unsigned)(m * 16) * rstride + bj * bjstride) = w;
                        if (wk) { float* o = ok + (unsigned)(ai * 128 + m * 16) * 512u + bj * 128; *(f32x4*)o = v0; *(f32x4*)(o + 4) = v1; } }
                    asm volatile("" ::: "memory"); } }
        }
    }
};
#undef NV0
#undef NV1
struct EpiRes {
    static constexpr bool PERM = true, AFTER_DRAIN = false;
    const float *base_lo, *base_hi; float* xout; int goff;
    unsigned char* wsb; int wp_idx; PG8_LAS float* sred;
    __device__ __forceinline__ void operator()(const f32x4 (&acc)[2][2][4][2], const Unit& u, int wr, int wc, int fr, int fq) const {
        const float* wprime = wp_idx >= 0 ? (const float*)(wsb + WS_WP) + (size_t)wp_idx * 9 * 1024 : (const float*)nullptr; bf16_t* AN = (bf16_t*)(wsb + WS_HN); float* PART = (float*)(wsb + WS_PART);
        const int pm = u.pm; const int mg = pm < 16 ? 0 : 1 + ((pm - 16) >> 4);
        const float* bs = pm < 16 ? base_lo + (size_t)pm * 256 * DM : base_hi + (size_t)(pm - 16) * 256 * DM;
        float* xo = xout + (size_t)pm * 256 * DM;
        const int col0 = u.pn * 256 + wc * 32 + 8 * fq; const float* gp = (const float*)(wsb + WS_MODS) + mg * 6144 + goff + col0;
        float ss[2][4];
#pragma unroll
        for (int ai = 0; ai < 2; ++ai)
#pragma unroll
            for (int m = 0; m < 4; ++m) ss[ai][m] = 0.f;
#pragma unroll
        for (int bj = 0; bj < 2; ++bj) {
            const f32x4 g0 = *(const f32x4*)(gp + bj * 128), g1 = *(const f32x4*)(gp + bj * 128 + 4);
            f32x4 w0 = g0, w1 = g1; if (wprime) { const float* wp = wprime + mg * 1024 + col0 + bj * 128; w0 = *(const f32x4*)wp; w1 = *(const f32x4*)(wp + 4); }
#pragma unroll
            for (int ai = 0; ai < 2; ++ai)
#pragma unroll
                for (int m = 0; m < 4; ++m) { unsigned off = (unsigned)(wr * 64 + fr + ai * 128 + m * 16) * DM + col0 + bj * 128; asm volatile("" : "+v"(off));
                    bf16_t* xrow = (bf16_t*)xo + 2u * (off - (col0 + bj * 128)) + 1024 + col0 + bj * 128;
                    f32x4 b0, b1;
                    if (base_lo) { b0 = *(const f32x4*)(bs + off); b1 = *(const f32x4*)(bs + off + 4); }
                    else { const u32x4 rw = *(const u32x4*)xrow; b0 = (f32x4){__uint_as_float(rw.x << 16), __uint_as_float(rw.x & 0xffff0000u), __uint_as_float(rw.y << 16), __uint_as_float(rw.y & 0xffff0000u)};
                        b1 = (f32x4){__uint_as_float(rw.z << 16), __uint_as_float(rw.z & 0xffff0000u), __uint_as_float(rw.w << 16), __uint_as_float(rw.w & 0xffff0000u)}; }
                    const f32x4 x0 = b0 + g0 * acc[ai][bj][m][0], x1 = b1 + g1 * acc[ai][bj][m][1];
                    { u32x4 xw; xw.x = cvt_pk_bf16(x0[0], x0[1]); xw.y = cvt_pk_bf16(x0[2], x0[3]); xw.z = cvt_pk_bf16(x1[0], x1[1]); xw.w = cvt_pk_bf16(x1[2], x1[3]); *(u32x4*)xrow = xw; }
                    if (wprime) { ss[ai][m] += ((x0[0] * x0[0] + x0[1] * x0[1]) + (x0[2] * x0[2] + x0[3] * x0[3])) + ((x1[0] * x1[0] + x1[1] * x1[1]) + (x1[2] * x1[2] + x1[3] * x1[3]));
                        const f32x4 a0 = x0 * w0, a1 = x1 * w1; u32x4 w; w.x = cvt_pk_bf16(a0[0], a0[1]); w.y = cvt_pk_bf16(a0[2], a0[3]); w.z = cvt_pk_bf16(a1[0], a1[1]); w.w = cvt_pk_bf16(a1[2], a1[3]);
                        *(u32x4*)(AN + (size_t)pm * 256 * DM + off) = w; }
                    if (m == 3) asm volatile("" ::: "memory"); }
        }
        if (wp_idx >= 0) {
#pragma unroll
            for (int ai = 0; ai < 2; ++ai)
#pragma unroll
                for (int m = 0; m < 4; ++m) { float t = ss[ai][m]; t += __shfl_xor(t, 16); t += __shfl_xor(t, 32);
                    if (fq == 0) sred[(wr * 64 + fr + ai * 128 + m * 16) * 4 + wc] = t; }
            asm volatile("s_waitcnt lgkmcnt(0)" ::: "memory"); __builtin_amdgcn_s_barrier(); asm volatile("" ::: "memory");
            const int t_ = (wr * 4 + wc) * 64 + fq * 16 + fr;
            if (t_ < 256) { const f32x4 v = *(const PG8_LAS f32x4*)(sred + t_ * 4); PART[((size_t)pm * 256 + t_) * 4 + u.pn] = (v[0] + v[1]) + (v[2] + v[3]); }
        }
    }
};
struct EpiGU {
    static constexpr bool PERM = true, AFTER_DRAIN = false;
    bf16_t* ACT; PG8_LAS float* srstd; mutable int ecnt;
    __device__ __forceinline__ void operator()(const f32x4 (&acc)[2][2][4][2], const Unit& u, int wr, int wc, int fr, int fq) const {
        const int col0 = u.pn * 128 + wc * 32 + 8 * fq;
        float rstd[2][4]; row_rstd(srstd, ecnt & 1, wr, fr, rstd);
        const PG8_LAS float* bp = srstd + 512 + (ecnt & 1) * 256 + wc * 32 + 8 * fq; ++ecnt;
        f32x4 bg[2], bu[2];
#pragma unroll
        for (int n = 0; n < 2; ++n) { bg[n] = *(const PG8_LAS f32x4*)(bp + 4 * n); bu[n] = *(const PG8_LAS f32x4*)(bp + 128 + 4 * n); }
#pragma unroll
        for (int ai = 0; ai < 2; ++ai)
#pragma unroll
            for (int m = 0; m < 4; ++m) { const size_t row = (size_t)u.pm * 256 + wr * 64 + fr + ai * 128 + m * 16; float o[8];
#pragma unroll
                for (int n = 0; n < 2; ++n) { const f32x4 gt = acc[ai][0][m][n] * rstd[ai][m] + bg[n], up = acc[ai][1][m][n] * rstd[ai][m] + bu[n];
#pragma unroll
                    for (int e = 0; e < 4; ++e) o[4 * n + e] = gt[e] * sigm(gt[e]) * up[e]; }
                u32x4 w; w.x = cvt_pk_bf16(o[0], o[1]); w.y = cvt_pk_bf16(o[2], o[3]); w.z = cvt_pk_bf16(o[4], o[5]); w.w = cvt_pk_bf16(o[6], o[7]);
                *(u32x4*)(ACT + row * DFF + col0) = w; }
    }
};
template <class Epi, class Sched, bool ALIGN_EPI = false, bool SP2 = false>
__device__ __forceinline__ void gemm_phase(PG8_LAS unsigned char* lds, const Gemm g, const Sched& S, const Epi& E) {
    int tid = threadIdx.x; asm volatile("" : "+v"(tid));
    const int wid = __builtin_amdgcn_readfirstlane(tid >> 6), lane = tid & 63, wr = wid >> 2, wc = wid & 3, fr = lane & 15, fq = lane >> 4;
    const int K = g.K, nt = K / BK;
    unsigned voffA[2], voffB[2];
#pragma unroll
    for (int i = 0; i < 2; ++i) { int R, C; stage_rc(tid * 16 + i * 8192, R, C); const int Rb = Epi::PERM ? ((R & ~31) + perm32(R & 31)) : R;
        voffA[i] = (unsigned)(R * K + C) * 2u; voffB[i] = (unsigned)(Rb * K + C) * 2u; }
    const size_t kstep = (size_t)(BK * 2);
    const size_t hstep = (size_t)HALF * K * 2;
    const size_t tstep = 2 * hstep;
    const unsigned ldsw = (unsigned)wid * 1024u;
    const int aoff = lds_byte(wr * 64 + fr, fq * 8), boff = lds_byte(wc * 32 + fr, fq * 8);
#define PG8_SA(b, h) (((b) * 2 + (h)) * HTB)
#define PG8_SB(b, h) ((4 + (b) * 2 + (h)) * HTB)
#define PG8_STAGE(bufoff, gbase, voff) do { _Pragma("unroll") for (int _i = 0; _i < 2; ++_i) \
        __builtin_amdgcn_global_load_lds((const unsigned*)((const char*)(gbase) + (voff)[_i]), (PG8_LAS unsigned*)(lds + (bufoff) + ldsw + _i * 8192), 16, 0, 0); } while (0)
#define PG8_LDA(dst, b, h) do { _Pragma("unroll") for (int m = 0; m < 4; ++m) _Pragma("unroll") for (int k = 0; k < 2; ++k) dst[m][k] = *(const PG8_LAS bf16x8*)(lds + PG8_SA(b, h) + aoff + m * 2048 + k * 1024); } while (0)
#define PG8_LDB(dst, b, h) do { _Pragma("unroll") for (int n = 0; n < 2; ++n) _Pragma("unroll") for (int k = 0; k < 2; ++k) dst[n][k] = *(const PG8_LAS bf16x8*)(lds + PG8_SB(b, h) + boff + n * 2048 + k * 1024); } while (0)
#define PG8_MMA(ai, bj, At, Bt) do { __builtin_amdgcn_s_setprio(1); _Pragma("unroll") for (int m = 0; m < 4; ++m) _Pragma("unroll") for (int n = 0; n < 2; ++n) _Pragma("unroll") for (int k = 0; k < 2; ++k) \
        acc[ai][bj][m][n] = __builtin_amdgcn_mfma_f32_16x16x32_bf16(Bt[n][k], At[m][k], acc[ai][bj][m][n], 0, 0, 0); __builtin_amdgcn_s_setprio(0); } while (0)
#define PG8_WAIT_V(n) asm volatile("s_waitcnt vmcnt(" #n ")" ::: "memory")
#define PG8_WAIT_L(n) asm volatile("s_waitcnt lgkmcnt(" #n ")" ::: "memory")
#define PG8_BAR __builtin_amdgcn_s_barrier()
#define PG8_SCHED __builtin_amdgcn_sched_barrier(0)
    Unit cur, nxt; int ui = 0;
    if (!S.next(0, cur)) return;
    f32x4 acc[2][2][4][2];
#pragma unroll
    for (int a = 0; a < 2; ++a)
#pragma unroll
        for (int b = 0; b < 2; ++b)
#pragma unroll
            for (int m = 0; m < 4; ++m)
#pragma unroll
                for (int n = 0; n < 2; ++n) acc[a][b][m][n] = (f32x4){0.f, 0.f, 0.f, 0.f};
    bf16x8 At[4][2], B0[2][2], B1[2][2];
    const char* cA = (const char*)g.A + (size_t)cur.pm * tstep; const char* cB = (const char*)g.Bt + (size_t)cur.pn * tstep;
    f32x4 hookv = S.a_ready(cur); S.a_finish(hookv);
    if constexpr (SP2) {
        PG8_STAGE(PG8_SB(0, 0), cB, voffB); PG8_STAGE(PG8_SB(0, 1), cB + hstep, voffB); PG8_STAGE(PG8_SA(0, 0), cA, voffA); PG8_STAGE(PG8_SA(0, 1), cA + hstep, voffA);
        if (wr == 1) PG8_BAR;
        PG8_WAIT_V(2); PG8_BAR;
        PG8_STAGE(PG8_SB(1, 0), cB + kstep, voffB); PG8_STAGE(PG8_SA(1, 0), cA + kstep, voffA); PG8_STAGE(PG8_SB(1, 1), cB + hstep + kstep, voffB);
        PG8_WAIT_V(6); PG8_BAR;
    } else {
        PG8_STAGE(PG8_SB(0, 0), cB, voffB); PG8_STAGE(PG8_SA(0, 0), cA, voffA); PG8_STAGE(PG8_SB(0, 1), cB + hstep, voffB); PG8_STAGE(PG8_SA(0, 1), cA + hstep, voffA);
        if (wr == 1) PG8_BAR;
        PG8_WAIT_V(4); PG8_BAR;
        PG8_STAGE(PG8_SB(1, 0), cB + kstep, voffB); PG8_STAGE(PG8_SA(1, 0), cA + kstep, voffA); PG8_STAGE(PG8_SB(1, 1), cB + hstep + kstep, voffB);
        PG8_WAIT_V(6); PG8_BAR;
    }
    for (;;) {
        const bool has_next = S.next(ui + 1, nxt);
        const char* nA = has_next ? (const char*)g.A + (size_t)nxt.pm * tstep : cA; const char* nB = has_next ? (const char*)g.Bt + (size_t)nxt.pn * tstep : cB;
        for (int t = 0; t < nt; t += 2) {
            const bool last = (t == nt - 2);
            const char* a1 = cA + (size_t)(t + 1) * kstep;
            const char* a2 = last ? nA : cA + (size_t)(t + 2) * kstep; const char* b2 = last ? nB : cB + (size_t)(t + 2) * kstep;
            const char* a3 = a2 + kstep; const char* b3 = b2 + kstep;
            if (last && has_next) hookv = S.a_ready(nxt);
            if constexpr (SP2) {
            PG8_LDB(B0, 0, 0); PG8_LDB(B1, 0, 1); PG8_SCHED; PG8_LDA(At, 0, 0); PG8_STAGE(PG8_SA(1, 1), a1 + hstep, voffA);
            PG8_WAIT_V(8); PG8_WAIT_L(0); PG8_BAR; PG8_MMA(0, 0, At, B0); PG8_MMA(0, 1, At, B1); PG8_BAR; PG8_SCHED;
            PG8_LDA(At, 0, 1); PG8_STAGE(PG8_SB(0, 0), b2, voffB); PG8_STAGE(PG8_SB(0, 1), b2 + hstep, voffB); PG8_STAGE(PG8_SA(0, 0), a2, voffA);
            PG8_WAIT_V(8); PG8_WAIT_L(0); PG8_BAR; PG8_MMA(1, 0, At, B0); PG8_MMA(1, 1, At, B1); PG8_BAR; PG8_SCHED;
            PG8_LDB(B0, 1, 0); PG8_LDB(B1, 1, 1); PG8_SCHED; PG8_LDA(At, 1, 0); PG8_STAGE(PG8_SA(0, 1), a2 + hstep, voffA);
            PG8_WAIT_V(8); PG8_WAIT_L(0); PG8_BAR; PG8_MMA(0, 0, At, B0); PG8_MMA(0, 1, At, B1); PG8_BAR; PG8_SCHED;
            PG8_LDA(At, 1, 1); PG8_STAGE(PG8_SB(1, 0), b3, voffB); PG8_STAGE(PG8_SB(1, 1), b3 + hstep, voffB); PG8_STAGE(PG8_SA(1, 0), a3, voffA);
            PG8_WAIT_V(8); PG8_WAIT_L(0); PG8_BAR; PG8_MMA(1, 0, At, B0); PG8_MMA(1, 1, At, B1); PG8_BAR; PG8_SCHED;
            } else {
            PG8_LDB(B0, 0, 0); PG8_SCHED; PG8_LDA(At, 0, 0); PG8_STAGE(PG8_SA(1, 1), a1 + hstep, voffA);
            PG8_WAIT_L(8); PG8_BAR; PG8_WAIT_L(0); PG8_MMA(0, 0, At, B0); PG8_BAR; PG8_SCHED;
            PG8_LDB(B1, 0, 1); PG8_STAGE(PG8_SB(0, 0), b2, voffB);
            PG8_BAR; PG8_WAIT_L(0); PG8_MMA(0, 1, At, B1); PG8_BAR;
            PG8_LDA(At, 0, 1); PG8_STAGE(PG8_SA(0, 0), a2, voffA);
            PG8_BAR; PG8_WAIT_L(0); PG8_MMA(1, 0, At, B0); PG8_BAR; PG8_SCHED;
            PG8_STAGE(PG8_SB(0, 1), b2 + hstep, voffB);
            PG8_WAIT_V(6); PG8_BAR; PG8_MMA(1, 1, At, B1); PG8_BAR;
            PG8_LDB(B0, 1, 0); PG8_SCHED; PG8_LDA(At, 1, 0); PG8_STAGE(PG8_SA(0, 1), a2 + hstep, voffA);
            PG8_WAIT_L(8); PG8_BAR; PG8_WAIT_L(0); PG8_MMA(0, 0, At, B0); PG8_BAR; PG8_SCHED;
            PG8_LDB(B1, 1, 1); PG8_STAGE(PG8_SB(1, 0), b3, voffB);
            PG8_BAR; PG8_WAIT_L(0); PG8_MMA(0, 1, At, B1); PG8_BAR;
            PG8_LDA(At, 1, 1); PG8_STAGE(PG8_SA(1, 0), a3, voffA);
            PG8_BAR; PG8_WAIT_L(0); PG8_MMA(1, 0, At, B0); PG8_BAR; PG8_SCHED;
            PG8_STAGE(PG8_SB(1, 1), b3 + hstep, voffB);
            PG8_WAIT_V(6); PG8_BAR; PG8_MMA(1, 1, At, B1); PG8_BAR;
            }
            if (last && has_next) S.a_finish(hookv);
        }
        if constexpr (ALIGN_EPI) { if (wr == 0) PG8_BAR; }
        if constexpr (!Epi::AFTER_DRAIN) { E(acc, cur, wr, wc, fr, fq); S.done(cur); }
        if (!has_next) break;
#pragma unroll
        for (int a = 0; a < 2; ++a)
#pragma unroll
            for (int b = 0; b < 2; ++b)
#pragma unroll
                for (int m = 0; m < 4; ++m)
#pragma unroll
                    for (int n = 0; n < 2; ++n) acc[a][b][m][n] = (f32x4){0.f, 0.f, 0.f, 0.f};
        cur = nxt; cA = nA; cB = nB; ++ui;
        if constexpr (ALIGN_EPI) { if (wr == 1) PG8_BAR; }
    }
    PG8_WAIT_V(0);
    if constexpr (!ALIGN_EPI) { if (wr == 0) PG8_BAR; }
    PG8_BAR;
    if constexpr (Epi::AFTER_DRAIN) { E.fused(acc, cur, wr, wc, fr, fq, lds, wid, lane); S.done(cur); }
#undef PG8_SA
#undef PG8_SB
#undef PG8_STAGE
#undef PG8_LDA
#undef PG8_LDB
#undef PG8_MMA
#undef PG8_WAIT_V
#undef PG8_WAIT_L
#undef PG8_BAR
#undef PG8_SCHED
}
}
#define LAS __attribute__((address_space(3)))
typedef unsigned short bf16;
typedef short bf16x8 __attribute__((ext_vector_type(8)));
typedef short s16x4 __attribute__((ext_vector_type(4)));
typedef float f32x4 __attribute__((ext_vector_type(4)));
typedef unsigned u32x4 __attribute__((ext_vector_type(4)));
typedef unsigned u32x2 __attribute__((ext_vector_type(2)));
constexpr int LDS_BYTES = 147456;
#define LDS_FENCE() asm volatile("s_waitcnt lgkmcnt(0)" ::: "memory")
constexpr float LOG2E = 1.4426950408889634f;
using pg8::cvt_pk_bf16; using pg8::sigm;
__device__ __forceinline__ float ex2(float x) { return __builtin_amdgcn_exp2f(x); }
__device__ __forceinline__ float wave_sum(float v) {
#pragma unroll
    for (int o = 1; o < 64; o <<= 1) v += __shfl_xor(v, o);
    return v;
}
struct Params { const float* in[25]; float* out; unsigned char* ws; int ph_lo, ph_hi; };

typedef __attribute__((address_space(1))) unsigned gu32;
#define XB_TMO      128
#define XB_XCNT(j)  (256  + 64 * (j))
#define XB_XSUB(j)  (1280 + 64 * (j))
#define XB_XGEN(j)  (2304 + 64 * (j))
#define XB_TOP      3328
#define XB_TOPGEN   3392
#define XCD_BAR_WORDS 3456
#define XB_SPIN_CAP (1u << 18)

__device__ __forceinline__ unsigned xb_ld(unsigned* p)              { return __hip_atomic_load(p, __ATOMIC_RELAXED, __HIP_MEMORY_SCOPE_AGENT); }
__device__ __forceinline__ unsigned xb_add(unsigned* p, unsigned v) { return __hip_atomic_fetch_add(p, v, __ATOMIC_RELAXED, __HIP_MEMORY_SCOPE_AGENT); }
__device__ __forceinline__ unsigned xb_xcc_id() { return (unsigned)__builtin_amdgcn_s_getreg((3 << 11) | 20) & 0xFu; }
#define XB_SPIN(cond, bar) do { unsigned _sp = 0; while (cond) { __builtin_amdgcn_s_sleep(1); \
    if ((++_sp & 255u) == 0u) { if (xb_ld(&(bar)[XB_TMO])) break; if (_sp > XB_SPIN_CAP) { atomicAdd(&(bar)[XB_TMO], 1u); break; } } } } while (0)

struct XcdBarrier {
    unsigned* bar; unsigned x;
    volatile LAS unsigned* st;
};

__device__ __forceinline__ XcdBarrier xcd_barrier_post(unsigned* bar, volatile LAS unsigned* st) {
    XcdBarrier b; b.bar = bar; b.x = xb_xcc_id(); b.st = st;
    if (threadIdx.x == 0) st[2] = xb_add(&bar[XB_XCNT(b.x)], 1u);
    return b;
}
__device__ __forceinline__ void xcd_barrier_complete(unsigned* bar, unsigned x, unsigned& nloc, unsigned& nx) {
    const unsigned G = gridDim.x * gridDim.y * gridDim.z;
    unsigned sum, cnt, mine, sp = 0u;
    for (;;) {
        sum = 0u; cnt = 0u; mine = 0u;
#pragma unroll
        for (unsigned j = 0; j < 16; ++j) { const unsigned c = xb_ld(&bar[XB_XCNT(j)]); sum += c; cnt += (c > 0u) ? 1u : 0u; mine = (j == x) ? c : mine; }
        if (sum == G) break;
        __builtin_amdgcn_s_sleep(1);
        if ((++sp & 255u) == 0u) { if (xb_ld(&bar[XB_TMO])) break; if (sp > XB_SPIN_CAP) { atomicAdd(&bar[XB_TMO], 1u); break; } }
    }
    nloc = mine > 0u ? mine : 1u; nx = cnt > 0u ? cnt : 1u;
}

__device__ __forceinline__ void xcd_barrier(const XcdBarrier& b) {
    asm volatile("s_waitcnt vmcnt(0)" ::: "memory");
    __syncthreads();
    if (threadIdx.x == 0) {
        unsigned* bar = b.bar;
        __builtin_amdgcn_s_waitcnt(0);
        unsigned nloc = b.st[0], nx = b.st[1];
        if (nloc == 0u) { xcd_barrier_complete(bar, b.x, nloc, nx); b.st[0] = nloc; b.st[1] = nx; }
        const unsigned old = xb_add(&bar[XB_XSUB(b.x)], 1u);
        const unsigned gen = old / nloc;
        if (old + 1u == (gen + 1u) * nloc) {
            __builtin_amdgcn_fence(__ATOMIC_RELEASE, "agent");
            asm volatile("s_waitcnt vmcnt(0)" ::: "memory");
            const unsigned og = xb_add(&bar[XB_TOP], 1u);
            const unsigned tg = og / nx;
            if (og + 1u == (tg + 1u) * nx) xb_add(&bar[XB_TOPGEN], 1u);
            else XB_SPIN(xb_ld(&bar[XB_TOPGEN]) == tg, bar);
            __builtin_amdgcn_fence(__ATOMIC_ACQUIRE, "agent");
            xb_add(&bar[XB_XGEN(b.x)], 1u);
            asm volatile("s_waitcnt vmcnt(0)" ::: "memory");
        } else {
            XB_SPIN(xb_ld(&bar[XB_XGEN(b.x)]) == gen, bar);
            __builtin_amdgcn_fence(__ATOMIC_ACQUIRE, "agent");
            asm volatile("s_waitcnt vmcnt(0)" ::: "memory");
        }
    }
    __syncthreads();
}
__device__ __forceinline__ void transpose_item(const float* W, int N, int k0, int n0, bf16* WT, int Kd, int drow0, LAS float* scr, int lane) {
#pragma unroll 8
    for (int i = 0; i < 32; ++i) { const int kk = 2 * i + (lane >> 5); scr[kk * 33 + (lane & 31)] = __builtin_nontemporal_load(&W[(size_t)(k0 + kk) * N + n0 + (lane & 31)]); }
    LDS_FENCE();
    const int c = lane & 7;
#pragma unroll
    for (int j = 0; j < 4; ++j) { const int n = (lane >> 3) + 8 * j; const LAS float* s = scr + (8 * c) * 33 + n;
        u32x4 o; o.x = cvt_pk_bf16(s[0 * 33], s[1 * 33]); o.y = cvt_pk_bf16(s[2 * 33], s[3 * 33]); o.z = cvt_pk_bf16(s[4 * 33], s[5 * 33]); o.w = cvt_pk_bf16(s[6 * 33], s[7 * 33]);
        *(u32x4*)(WT + (size_t)(drow0 + n) * Kd + k0 + 8 * c) = o; }
    LDS_FENCE();
}
__device__ __forceinline__ void convert_layer(const Params& P, unsigned char* ws, int l, LAS float* scr, int lane, int widx, int nw) {
    bf16 *WIN = (bf16*)(ws + WS_WIN), *WOUT = (bf16*)(ws + WS_WOUT), *WGU = (bf16*)(ws + WS_WGU), *WDN = (bf16*)(ws + WS_WDN);
    constexpr int PER_L = 1280 + 512 + 1408 + 1408 + 1408;
    for (int it = widx; it < PER_L; it += nw) { int r = it;
        if (r < 1280) { const int kb = r / 80, nb = r % 80; transpose_item(P.in[11] + (size_t)l * 1024 * 2560, 2560, 64 * kb, 32 * nb, WIN + (size_t)l * 2560 * 1024, 1024, 32 * nb, scr, lane); continue; } r -= 1280;
        if (r < 512) { const int kb = r / 32, nb = r % 32; transpose_item(P.in[12] + (size_t)l * 1024 * 1024, 1024, 64 * kb, 32 * nb, WOUT + (size_t)l * 1024 * 1024, 1024, 32 * nb, scr, lane); continue; } r -= 512;
        if (r < 2816) { const int up = r >= 1408; if (up) r -= 1408; const int kb = r / 88, nb = r % 88, n0 = 32 * nb;
            transpose_item(P.in[up ? 22 : 21] + (size_t)l * 1024 * 2816, 2816, 64 * kb, n0, WGU + (size_t)l * 5632 * 1024, 1024, 256 * (n0 >> 7) + (n0 & 127) + (up ? 128 : 0), scr, lane); continue; } r -= 2816;
        { const int kb = r / 32, nb = r % 32; transpose_item(P.in[23] + (size_t)l * 2816 * 1024, 1024, 64 * kb, 32 * nb, WDN + (size_t)l * 1024 * 2816, 2816, 32 * nb, scr, lane); }
    }
}
__device__ __forceinline__ void prologue(const Params& P, LAS unsigned char* lds, int tid, int wave, int lane) {
    unsigned char* ws = P.ws;
    {
        LAS float* S = (LAS float*)(lds + 67584);
        LAS float* R = (LAS float*)(lds + 67584 + 36864);
        for (int i = tid; i < 9 * 1024; i += 512) { const int v = i >> 10, k = i & 1023; const float x = v == 0 ? P.in[6][k] : P.in[5][(v - 1) * 1024 + k]; S[i] = x * sigm(x); }
        __syncthreads();
        float* MODS = (float*)(ws + WS_MODS);
        for (int it = blockIdx.x; it < 4 * 96; it += gridDim.x) {
            const int l = it / 96, cb = it % 96; const float* w = P.in[7] + (size_t)l * 1024 * 6144 + cb * 64 + lane;
            float a[9];
#pragma unroll
            for (int v = 0; v < 9; ++v) a[v] = 0.f;
            const int kb = wave * 128;
#pragma unroll 4
            for (int k = 0; k < 128; ++k) { const float wv = __builtin_nontemporal_load(&w[(size_t)(kb + k) * 6144]);
#pragma unroll
                for (int v = 0; v < 9; ++v) a[v] += S[v * 1024 + kb + k] * wv; }
#pragma unroll
            for (int v = 0; v < 9; ++v) R[(wave * 9 + v) * 64 + lane] = a[v];
            __syncthreads();
            for (int o = tid; o < 9 * 64; o += 512) { const int v = o >> 6, cidx = o & 63; float s = 0.f;
#pragma unroll
                for (int w8 = 0; w8 < 8; ++w8) s += R[(w8 * 9 + v) * 64 + cidx];
                MODS[((size_t)l * 9 + v) * 6144 + cb * 64 + cidx] = s + P.in[8][l * 6144 + cb * 64 + cidx]; }
            __syncthreads();
        }
    }
    {
        LAS float* scr = (LAS float*)(lds + wave * 8448);
        const int gw = blockIdx.x * 8 + wave, ngw = gridDim.x * 8;
        bf16* CVT = (bf16*)(ws + WS_CVT);
        convert_layer(P, ws, 0, scr, lane, gw, ngw);
        for (int r = gw; r < 2048; r += ngw) { const int bl = r >> 6, rr = r & 63, kb = rr >> 4, nb = rr & 15;
            transpose_item(P.in[3] + (size_t)bl * 256 * 512, 512, 64 * kb, 32 * nb, CVT + ((size_t)(bl * 4 + kb) * 8 + (nb >> 1)) * 4096 - 64 * kb, 64, (nb & 1) * 32, scr, lane); }
    }
    {
        const int gt = blockIdx.x * 512 + tid, ngt = gridDim.x * 512;
        bf16* CK = (bf16*)(ws + WS_CK);
        for (int i = gt; i < 8 * 4 * 256 * 512 / 8; i += ngt) { const f32x4 a = *(const f32x4*)(P.in[2] + (size_t)i * 8), b = *(const f32x4*)(P.in[2] + (size_t)i * 8 + 4);
            u32x4 w; w.x = cvt_pk_bf16(a[0], a[1]); w.y = cvt_pk_bf16(a[2], a[3]); w.z = cvt_pk_bf16(b[0], b[1]); w.w = cvt_pk_bf16(b[2], b[3]); const int e = i * 8, col = e & 511, rowi = e >> 9, tok = rowi & 63, chunk = rowi >> 6; *(u32x4*)(CK + ((size_t)(chunk * 8 + (col >> 6)) * 64 + tok) * 64 + (col & 63)) = w; }
        bf16* WL = (bf16*)(ws + WS_LRUW);
        for (int o = gt; o < 4 * 2 * 2 * 8 * 4096; o += ngt) { const int j = o & 63, k = (o >> 6) & 63, n = (o >> 12) & 7, ri = (o >> 15) & 1, ld = o >> 16;
            const float v = P.in[ri ? 19 : 17][((size_t)(ld * 8 + n) * 64 + j) * 64 + k]; WL[o] = (bf16)(cvt_pk_bf16(v, 0.f) & 0xffffu); }
    }
}
__device__ __forceinline__ void norm_mod_phase(const float* x_lo, const float* x_hi, const float* normw, const float* mods, int shoff, int scoff, bf16* HN, int gw, int ngw, int lane) {
    for (int row = gw; row < MTOK; row += ngw) {
        const float* xr = row < NCTX ? x_lo + (size_t)row * DM : x_hi + (size_t)(row - NCTX) * DM;
        const int mg = row < NCTX ? 0 : 1 + ((row - NCTX) >> 12);
        f32x4 v[4]; float s = 0.f;
#pragma unroll
        for (int j = 0; j < 4; ++j) { v[j] = *(const f32x4*)(xr + 256 * j + 4 * lane); s += (v[j][0] * v[j][0] + v[j][1] * v[j][1]) + (v[j][2] * v[j][2] + v[j][3] * v[j][3]); }
        const float rstd = 1.0f / sqrtf(wave_sum(s) * (1.f / DM) + 1e-6f);
        const float* mp = mods + mg * 6144;
#pragma unroll
        for (int j = 0; j < 4; ++j) { const int c = 256 * j + 4 * lane; const f32x4 w = *(const f32x4*)(normw + c), sc = *(const f32x4*)(mp + scoff + c), sh = *(const f32x4*)(mp + shoff + c);
            const f32x4 o = (v[j] * rstd * w) * (sc + 1.0f) + sh; u32x2 pk; pk.x = cvt_pk_bf16(o[0], o[1]); pk.y = cvt_pk_bf16(o[2], o[3]); *(u32x2*)(HN + (size_t)row * DM + c) = pk; }
    }
}
__device__ __forceinline__ void final_norm_phase(float* x, const float* normw, int gw, int ngw, int lane) {
    for (int row = gw; row < MTOK; row += ngw) {
        float* xr = x + (size_t)row * DM; const bf16* xb = (const bf16*)xr + 1024; f32x4 v[4]; float s = 0.f;
#pragma unroll
        for (int j = 0; j < 4; ++j) { const u32x2 rw = *(const u32x2*)(xb + 256 * j + 4 * lane);
            v[j] = (f32x4){__uint_as_float(rw.x << 16), __uint_as_float(rw.x & 0xffff0000u), __uint_as_float(rw.y << 16), __uint_as_float(rw.y & 0xffff0000u)};
            s += (v[j][0] * v[j][0] + v[j][1] * v[j][1]) + (v[j][2] * v[j][2] + v[j][3] * v[j][3]); }
        const float rstd = 1.0f / sqrtf(wave_sum(s) * (1.f / DM) + 1e-6f);
        asm volatile("s_waitcnt vmcnt(0)" ::: "memory");
#pragma unroll
        for (int j = 0; j < 4; ++j) { const int c = 256 * j + 4 * lane; const f32x4 w = *(const f32x4*)(normw + c); *(f32x4*)(xr + c) = v[j] * rstd * w; }
    }
}
#define MFMA16(a, b, c) __builtin_amdgcn_mfma_f32_16x16x32_bf16((a), (b), (c), 0, 0, 0)
#define USED(kt, qtg) (!LOCAL || ((kt) - (qtg) <= 1 && (qtg) - (kt) <= 1))
#define PIN_MEM() asm volatile("" ::: "memory")
__device__ __forceinline__ void attn_load_k(const bf16* Kp, bf16x8 (&kf)[4][2], int g, int c16) {
#pragma unroll
    for (int kt = 0; kt < 4; ++kt) { const bf16* kr = Kp + (16 * kt + c16) * 64 + 8 * g; kf[kt][0] = *(const bf16x8*)kr; kf[kt][1] = *(const bf16x8*)(kr + 32); }
}
__device__ __forceinline__ void attn_load_v(const bf16* VTp, int vstride, s16x4 (&va)[2][4], s16x4 (&vb)[2][4], int g, int c16) {
#pragma unroll
    for (int kp = 0; kp < 2; ++kp)
#pragma unroll
        for (int dt = 0; dt < 4; ++dt) { const bf16* vr = VTp + (16 * dt + c16) * 64 + 32 * kp + 4 * g; va[kp][dt] = *(const s16x4*)vr; vb[kp][dt] = *(const s16x4*)(vr + 16); }
}
template <bool LOCAL, int QH>
__device__ __forceinline__ void attn_qk(f32x4 (&S)[4][2], const bf16x8 (&kf)[4][2], const bf16x8 (&qf)[2][2]) {
    __builtin_amdgcn_s_setprio(1);
#pragma unroll
    for (int kt = 0; kt < 4; ++kt)
#pragma unroll
        for (int qi = 0; qi < 2; ++qi) if (USED(kt, 2 * QH + qi)) {
            f32x4 a = (f32x4){0.f, 0.f, 0.f, 0.f}; a = MFMA16(kf[kt][0], qf[qi][0], a); a = MFMA16(kf[kt][1], qf[qi][1], a); S[kt][qi] = a; }
    __builtin_amdgcn_s_setprio(0);
}
template <bool LOCAL, int QH>
__device__ __forceinline__ void attn_softmax(f32x4 (&S)[4][2], f32x4 (&O)[4][2], float (&mrow)[2], f32x4 (&L)[2], const LAS float* rp, const int (&lo)[2], bf16x8 (&pb)[2][2]) {
    constexpr float C1 = 0.125f * LOG2E;
    float mnew[2]; bool grow = false;
#pragma unroll
    for (int qi = 0; qi < 2; ++qi) { const int qtg = 2 * QH + qi;
        float mx = -1e30f;
#pragma unroll
        for (int kt = 0; kt < 4; ++kt) if (USED(kt, qtg)) {
#pragma unroll
            for (int j = 0; j < 4; ++j) {
                if (LOCAL) { float t = __builtin_fmaf(S[kt][qi][j], C1, rp[16 * (kt - qtg) + j]); t = ((unsigned)(16 * kt + j - lo[qi]) < 16u) ? t : -1e30f; S[kt][qi][j] = t; mx = fmaxf(mx, t); }
                else mx = fmaxf(mx, S[kt][qi][j]); } }
        if (!LOCAL) mx *= C1;
        mx = fmaxf(mx, __shfl_xor(mx, 16)); mx = fmaxf(mx, __shfl_xor(mx, 32));
        const bool gq = mx > mrow[qi] + 8.0f; mnew[qi] = gq ? mx : mrow[qi]; grow = grow || gq;
    }
    if (__any(grow)) {
#pragma unroll
        for (int qi = 0; qi < 2; ++qi) { const float alpha = ex2(mrow[qi] - mnew[qi]); mrow[qi] = mnew[qi]; L[qi] = L[qi] * alpha;
#pragma unroll
            for (int dt = 0; dt < 4; ++dt) O[dt][qi] = O[dt][qi] * alpha; }
    }
#pragma unroll
    for (int qi = 0; qi < 2; ++qi) { const int qtg = 2 * QH + qi; const float mref = mrow[qi];
#pragma unroll
        for (int kt = 0; kt < 4; ++kt) if (USED(kt, qtg)) {
#pragma unroll
            for (int j = 0; j < 4; ++j) S[kt][qi][j] = LOCAL ? ex2(S[kt][qi][j] - mref) : ex2(__builtin_fmaf(S[kt][qi][j], C1, -mref)); }
#pragma unroll
        for (int kp = 0; kp < 2; ++kp) { u32x4 w = (u32x4){0u, 0u, 0u, 0u};
            if (USED(2 * kp, qtg)) { w.x = cvt_pk_bf16(S[2 * kp][qi][0], S[2 * kp][qi][1]); w.y = cvt_pk_bf16(S[2 * kp][qi][2], S[2 * kp][qi][3]); }
            if (USED(2 * kp + 1, qtg)) { w.z = cvt_pk_bf16(S[2 * kp + 1][qi][0], S[2 * kp + 1][qi][1]); w.w = cvt_pk_bf16(S[2 * kp + 1][qi][2], S[2 * kp + 1][qi][3]); }
            pb[qi][kp] = __builtin_bit_cast(bf16x8, w); }
    }
}
template <bool LOCAL, int QH>
__device__ __forceinline__ void attn_pv(f32x4 (&O)[4][2], f32x4 (&L)[2], const bf16x8 (&pb)[2][2], const s16x4 (&va)[2][4], const s16x4 (&vb)[2][4]) {
    __builtin_amdgcn_s_setprio(1);
    const bf16x8 ones = (bf16x8){(short)0x3F80, (short)0x3F80, (short)0x3F80, (short)0x3F80, (short)0x3F80, (short)0x3F80, (short)0x3F80, (short)0x3F80};
#pragma unroll
    for (int kp = 0; kp < 2; ++kp) {
#pragma unroll
        for (int qi = 0; qi < 2; ++qi) if (!LOCAL || (kp == 0 ? (2 * QH + qi) <= 2 : (2 * QH + qi) >= 1)) L[qi] = MFMA16(ones, pb[qi][kp], L[qi]);
    }
#pragma unroll
    for (int kp = 0; kp < 2; ++kp)
#pragma unroll
        for (int dt = 0; dt < 4; ++dt) { const s16x4 a = va[kp][dt], b = vb[kp][dt];
            const bf16x8 vf = (bf16x8){a[0], a[1], a[2], a[3], b[0], b[1], b[2], b[3]};
#pragma unroll
            for (int qi = 0; qi < 2; ++qi) if (!LOCAL || (kp == 0 ? (2 * QH + qi) <= 2 : (2 * QH + qi) >= 1)) O[dt][qi] = MFMA16(vf, pb[qi][kp], O[dt][qi]); }
    __builtin_amdgcn_s_setprio(0);
}
template <int QH>
__device__ __forceinline__ void attn_half(int u, int layer, const unsigned char* ws, const LAS float* rpbs, int lane) {
    const int g = lane >> 4, c16 = lane & 15, h = u & 7;
    const bf16 *Q = (const bf16*)(ws + WS_Q), *K = (const bf16*)(ws + WS_K), *VT = (const bf16*)(ws + WS_VT), *CK = (const bf16*)(ws + WS_CK), *CVT = (const bf16*)(ws + WS_CVT);
    bf16* MIX = (bf16*)(ws + WS_MIX);
    const bool lat = u < 4096; int b, r = 0, qrow0;
    if (lat) { b = u >> 9; r = (u >> 3) & 63; qrow0 = NCTX + b * 4096 + r * 64; } else { const int uc = u - 4096; b = uc >> 5; qrow0 = b * 256 + ((uc >> 3) & 3) * 64; }
    qrow0 += 32 * QH;
    bf16x8 qf[2][2];
#pragma unroll
    for (int qi = 0; qi < 2; ++qi) { const bf16* qp = Q + (size_t)(qrow0 + 16 * qi + c16) * 512 + h * 64 + 8 * g; qf[qi][0] = *(const bf16x8*)qp; qf[qi][1] = *(const bf16x8*)(qp + 32); }
    f32x4 O[4][2], L[2]; float mrow[2]; int lo[2];
#pragma unroll
    for (int qi = 0; qi < 2; ++qi) { mrow[qi] = -1e30f; L[qi] = (f32x4){0.f, 0.f, 0.f, 0.f}; int cs = 32 * QH + 16 * qi + c16 - 8; cs = cs < 0 ? 0 : (cs > 48 ? 48 : cs); lo[qi] = cs - 4 * g;
#pragma unroll
        for (int dt = 0; dt < 4; ++dt) O[dt][qi] = (f32x4){0.f, 0.f, 0.f, 0.f}; }
    int rs = r - 4; rs = rs < 0 ? 0 : (rs > 56 ? 56 : rs);
    const int nloc = lat ? 8 : 0, ntot = lat ? 12 : 4;
    const bf16* Kloc = K + (size_t)((64 + b * 64 + rs) * 8 + h) * 4096; const bf16* Vloc = VT + (size_t)((64 + b * 64 + rs) * 8 + h) * 4096;
    const size_t dch = lat ? (size_t)((b * 4 + layer) * 4 * 8 + h) * 4096 : (size_t)(b * 4 * 8 + h) * 4096;
    const bf16* Kden = (lat ? CK : K) + dch; const bf16* Vden = (lat ? CVT : VT) + dch;
#define KPTR(i) ((i) < nloc ? Kloc + (size_t)(i) * 32768 : Kden + (size_t)((i) - nloc) * 32768)
#define VPTR(i) ((i) < nloc ? Vloc + (size_t)(i) * 32768 : Vden + (size_t)((i) - nloc) * 32768)
#define VSTR(i) 64
    bf16x8 kf[4][2]; s16x4 va[2][4], vb[2][4]; f32x4 S[4][2]; bf16x8 pb[2][2];
    attn_load_k(KPTR(0), kf, g, c16); PIN_MEM();
    const LAS float* rl = rpbs + (4 * g - c16 + 31) + (rs - r + 7) * 64;
#pragma unroll 1
    for (int i = 0; i < nloc; ++i) {
        attn_load_v(VPTR(i), VSTR(i), va, vb, g, c16); PIN_MEM();
        attn_qk<true, QH>(S, kf, qf); PIN_MEM(); attn_load_k(KPTR(i + 1), kf, g, c16); PIN_MEM();
        attn_softmax<true, QH>(S, O, mrow, L, rl + i * 64, lo, pb);
        attn_pv<true, QH>(O, L, pb, va, vb); PIN_MEM();
    }
#pragma unroll 1
    for (int i = nloc; i < ntot; ++i) { const int in_ = i + 1 < ntot ? i + 1 : i;
        attn_load_v(VPTR(i), VSTR(i), va, vb, g, c16); PIN_MEM();
        attn_qk<false, QH>(S, kf, qf); PIN_MEM(); attn_load_k(KPTR(in_), kf, g, c16); PIN_MEM();
        attn_softmax<false, QH>(S, O, mrow, L, rl, lo, pb);
        attn_pv<false, QH>(O, L, pb, va, vb); PIN_MEM();
    }
#undef KPTR
#undef VPTR
#undef VSTR
#pragma unroll
    for (int qi = 0; qi < 2; ++qi) { const float il = 1.0f / L[qi][0];
        bf16* op = MIX + (size_t)(qrow0 + 16 * qi + c16) * DM + h * 64 + 4 * g;
#pragma unroll
        for (int dt = 0; dt < 4; ++dt) { const f32x4 o = O[dt][qi] * il; u32x2 pk; pk.x = cvt_pk_bf16(o[0], o[1]); pk.y = cvt_pk_bf16(o[2], o[3]); *(u32x2*)(op + 16 * dt) = pk; } }
}
template <int QH>
__device__ __forceinline__ void attn_local_band(const LAS unsigned char* bufk, const LAS unsigned char* bufv, const bf16x8 (&qf)[2][2], f32x4 (&O)[4][2], float (&mrow)[2], f32x4 (&L)[2],
                                                const LAS float* rp, const int (&lo)[2], int g, int c16) {
    constexpr float C1 = 0.125f * LOG2E;
    f32x4 S[2][2]; float mnew[2]; bool grow = false;
#pragma unroll
    for (int qi = 0; qi < 2; ++qi) { const int qtg = 2 * QH + qi; const int st = qtg == 0 ? 0 : (qtg == 1 ? 8 : (qtg == 2 ? 24 : 32));
        float mx = -1e30f;
#pragma unroll
        for (int t = 0; t < 2; ++t) { const int row = st + 16 * t + c16;
            const bf16x8 k0 = *(const LAS bf16x8*)(bufk + row * 128 + ((g ^ (row & 7)) << 4)), k1 = *(const LAS bf16x8*)(bufk + row * 128 + (((4 + g) ^ (row & 7)) << 4));
            f32x4 a = (f32x4){0.f, 0.f, 0.f, 0.f}; a = MFMA16(k0, qf[qi][0], a); a = MFMA16(k1, qf[qi][1], a);
#pragma unroll
            for (int j = 0; j < 4; ++j) { float v = __builtin_fmaf(a[j], C1, rp[st - 16 * qtg + 16 * t + j]); v = ((unsigned)(st + 16 * t + j - lo[qi]) < 16u) ? v : -1e30f; a[j] = v; mx = fmaxf(mx, v); }
            S[qi][t] = a; }
        mx = fmaxf(mx, __shfl_xor(mx, 16)); mx = fmaxf(mx, __shfl_xor(mx, 32));
        const bool gq = mx > mrow[qi] + 8.0f; mnew[qi] = gq ? mx : mrow[qi]; grow = grow || gq;
    }
    if (__any(grow)) {
#pragma unroll
        for (int qi = 0; qi < 2; ++qi) { const float alpha = ex2(mrow[qi] - mnew[qi]); mrow[qi] = mnew[qi]; L[qi] = L[qi] * alpha;
#pragma unroll
            for (int dt = 0; dt < 4; ++dt) O[dt][qi] = O[dt][qi] * alpha; }
    }
    const bf16x8 ones = (bf16x8){(short)0x3F80, (short)0x3F80, (short)0x3F80, (short)0x3F80, (short)0x3F80, (short)0x3F80, (short)0x3F80, (short)0x3F80};
#pragma unroll
    for (int qi = 0; qi < 2; ++qi) { const int qtg = 2 * QH + qi; const int st = qtg == 0 ? 0 : (qtg == 1 ? 8 : (qtg == 2 ? 24 : 32)); const float mref = mrow[qi];
        u32x4 w;
        { const f32x4 a = S[qi][0], b = S[qi][1];
          w.x = cvt_pk_bf16(ex2(a[0] - mref), ex2(a[1] - mref)); w.y = cvt_pk_bf16(ex2(a[2] - mref), ex2(a[3] - mref));
          w.z = cvt_pk_bf16(ex2(b[0] - mref), ex2(b[1] - mref)); w.w = cvt_pk_bf16(ex2(b[2] - mref), ex2(b[3] - mref)); }
        const bf16x8 pb = __builtin_bit_cast(bf16x8, w);
        L[qi] = MFMA16(ones, pb, L[qi]);
#pragma unroll
        for (int dt = 0; dt < 4; ++dt) { const int row = 16 * dt + c16, ch = (st >> 3) + (g >> 1);
            const s16x4 va = *(const LAS s16x4*)(bufv + row * 128 + ((ch ^ (row & 7)) << 4) + (g & 1) * 8), vb = *(const LAS s16x4*)(bufv + row * 128 + (((ch + 2) ^ (row & 7)) << 4) + (g & 1) * 8);
            const bf16x8 vf = (bf16x8){va[0], va[1], va[2], va[3], vb[0], vb[1], vb[2], vb[3]};
            O[dt][qi] = MFMA16(vf, pb, O[dt][qi]); }
    }
}
template <int QH>
__device__ __forceinline__ void attn_wg_half(bool lat, int b, int h, int r0, int layer, const unsigned char* ws, const LAS float* rpbs, LAS unsigned char* stg, int tid, int wave, int lane) {
    const int g = lane >> 4, c16 = lane & 15, qsub = wave >> 1;
    const bf16 *Q = (const bf16*)(ws + WS_Q), *K = (const bf16*)(ws + WS_K), *VT = (const bf16*)(ws + WS_VT), *CK = (const bf16*)(ws + WS_CK), *CVT = (const bf16*)(ws + WS_CVT);
    bf16* MIX = (bf16*)(ws + WS_MIX);
    const int r = r0 + qsub; const int qrow0 = (lat ? NCTX + b * 4096 + r * 64 : b * 256 + qsub * 64) + 32 * QH;
    bf16x8 qf[2][2];
#pragma unroll
    for (int qi = 0; qi < 2; ++qi) { const bf16* qp = Q + (size_t)(qrow0 + 16 * qi + c16) * 512 + h * 64 + 8 * g; qf[qi][0] = *(const bf16x8*)qp; qf[qi][1] = *(const bf16x8*)(qp + 32); }
    f32x4 O[4][2], L[2]; float mrow[2]; int lo[2];
#pragma unroll
    for (int qi = 0; qi < 2; ++qi) { mrow[qi] = -1e30f; L[qi] = (f32x4){0.f, 0.f, 0.f, 0.f}; int cs = 32 * QH + 16 * qi + c16 - 8; cs = cs < 0 ? 0 : (cs > 48 ? 48 : cs); lo[qi] = cs - 4 * g;
#pragma unroll
        for (int dt = 0; dt < 4; ++dt) O[dt][qi] = (f32x4){0.f, 0.f, 0.f, 0.f}; }
    int rs = r - 4; rs = rs < 0 ? 0 : (rs > 56 ? 56 : rs);
    int U0 = r0 - 4; U0 = U0 < 0 ? 0 : (U0 > 56 ? 56 : U0); int U1 = r0 - 1; U1 = (U1 < 0 ? 0 : (U1 > 56 ? 56 : U1)) + 7;
    const int nU = lat ? U1 - U0 + 1 : 0, ntot = nU + 4;
    const size_t loc0 = (size_t)((64 + b * 64 + U0) * 8 + h) * 4096, den0 = lat ? (size_t)((b * 4 + layer) * 4 * 8 + h) * 4096 : (size_t)(b * 4 * 8 + h) * 4096;
    const bf16 *Kd = lat ? CK : K, *Vd = lat ? CVT : VT;
#define TILE_K(s_) ((s_) < nU ? K + loc0 + (size_t)(s_) * 32768 : Kd + den0 + (size_t)((s_) - nU) * 32768)
#define TILE_V(s_) ((s_) < nU ? VT + loc0 + (size_t)(s_) * 32768 : Vd + den0 + (size_t)((s_) - nU) * 32768)
    const int srow = tid >> 3, wpos = srow * 128 + (((tid & 7) ^ (srow & 7)) << 4);
    const LAS float* rl = rpbs + (4 * g - c16 + 31);
    u32x4 kreg = *(const u32x4*)(TILE_K(0) + tid * 8), vreg = *(const u32x4*)(TILE_V(0) + tid * 8);
    *(LAS u32x4*)(stg + wpos) = kreg; *(LAS u32x4*)(stg + 8192 + wpos) = vreg;
    kreg = *(const u32x4*)(TILE_K(1) + tid * 8); vreg = *(const u32x4*)(TILE_V(1) + tid * 8);
    u32x4 kreg2 = kreg, vreg2 = vreg;
    __syncthreads();
#pragma unroll 1
    for (int s_ = 0; s_ < ntot; ++s_) {
        const bool more = s_ + 1 < ntot;
        if (s_ + 2 < ntot) { kreg2 = *(const u32x4*)(TILE_K(s_ + 2) + tid * 8); vreg2 = *(const u32x4*)(TILE_V(s_ + 2) + tid * 8); }
        PIN_MEM();
        const LAS unsigned char* bufk = stg + (s_ & 1) * 16384; const LAS unsigned char* bufv = bufk + 8192;
        const int kro = U0 + s_; const bool local = s_ < nU;
        if (local) { if (kro >= rs && kro <= rs + 7) attn_local_band<QH>(bufk, bufv, qf, O, mrow, L, rl + (kro - r + 7) * 64, lo, g, c16); }
        else {
            f32x4 S[4][2]; bf16x8 pb[2][2];
            { bf16x8 kf[4][2];
#pragma unroll
              for (int kt = 0; kt < 4; ++kt) { const int row = 16 * kt + c16;
#pragma unroll
                for (int ks = 0; ks < 2; ++ks) kf[kt][ks] = *(const LAS bf16x8*)(bufk + row * 128 + (((ks * 4 + g) ^ (row & 7)) << 4)); }
              attn_qk<false, QH>(S, kf, qf); }
            PIN_MEM();
            attn_softmax<false, QH>(S, O, mrow, L, rl, lo, pb);
            PIN_MEM();
            { s16x4 va[2][4], vb[2][4];
#pragma unroll
              for (int kp = 0; kp < 2; ++kp)
#pragma unroll
                for (int dt = 0; dt < 4; ++dt) { const int row = 16 * dt + c16, ch = kp * 4 + (g >> 1);
                    va[kp][dt] = *(const LAS s16x4*)(bufv + row * 128 + ((ch ^ (row & 7)) << 4) + (g & 1) * 8);
                    vb[kp][dt] = *(const LAS s16x4*)(bufv + row * 128 + (((ch + 2) ^ (row & 7)) << 4) + (g & 1) * 8); }
              attn_pv<false, QH>(O, L, pb, va, vb); }
        }
        if (more) { LAS unsigned char* nb = stg + ((s_ + 1) & 1) * 16384; *(LAS u32x4*)(nb + wpos) = kreg; *(LAS u32x4*)(nb + 8192 + wpos) = vreg; }
        kreg = kreg2; vreg = vreg2;
        __syncthreads();
    }
#undef TILE_K
#undef TILE_V
#pragma unroll
    for (int qi = 0; qi < 2; ++qi) { const float il = 1.0f / L[qi][0];
        bf16* op = MIX + (size_t)(qrow0 + 16 * qi + c16) * DM + h * 64 + 4 * g;
#pragma unroll
        for (int dt = 0; dt < 4; ++dt) { const f32x4 o = O[dt][qi] * il; u32x2 pk; pk.x = cvt_pk_bf16(o[0], o[1]); pk.y = cvt_pk_bf16(o[2], o[3]); *(u32x2*)(op + 16 * dt) = pk; } }
}
__device__ __forceinline__ void attn_unit(int u, int layer, const unsigned char* ws, const LAS float* rpbs, int lane) {
    attn_half<0>(u, layer, ws, rpbs, lane); attn_half<1>(u, layer, ws, rpbs, lane);
}
template <bool APPLY, bool SPLIT = true>
__device__ __forceinline__ void lru_unit(int u, int layer, const Params& P, LAS unsigned char* xsb, LAS unsigned char* xcb, LAS bf16* tsc, int lane) {
    const unsigned char* ws = P.ws;
    constexpr int LSTR = 72;
    const int g = lane >> 4, c16 = lane & 15, hf = SPLIT ? (u & 1) : 0, n = SPLIT ? ((u >> 1) & 7) : (u & 7), cgi = SPLIT ? (u >> 4) : (u >> 3);
    const bool ctx = cgi < 64; const int b = ctx ? cgi >> 2 : (cgi - 64) >> 6, ci = ctx ? cgi & 3 : (cgi - 64) & 63, nc = ctx ? 4 : 64, cg0 = cgi - ci;
    const int row0 = cgi * 64;
    const bf16 *XB = (const bf16*)(ws + WS_XB), *YB = (const bf16*)(ws + WS_YB), *WL = (const bf16*)(ws + WS_LRUW);
    LAS bf16* xs = (LAS bf16*)xsb; LAS bf16* xct = SPLIT ? (LAS bf16*)xcb : xs; const int sub = SPLIT ? hf : 0;
    LDS_FENCE();
#pragma unroll
    for (int i = 0; i < 9; ++i) { const int rr = i * 8 + (lane >> 3); if (rr < 67 && (!SPLIT || ((rr < 34) == (sub == 0)))) { const bool ok = !((ci == 0 && rr < 2) || (ci == nc - 1 && rr == 66));
            u32x4 v = (u32x4){0u, 0u, 0u, 0u}; if (ok) v = *(const u32x4*)(XB + (size_t)(row0 - 2 + rr) * 512 + n * 64 + (lane & 7) * 8);
            *(LAS u32x4*)(xs + rr * LSTR + (lane & 7) * 8) = v; } }
    LDS_FENCE();
    if (SPLIT) __syncthreads();
    {
        u32x4 xcf[4][2];
        const float* cw = P.in[14] + (size_t)layer * 4 * 512 + n * 64; const float* cb = P.in[15] + layer * 512 + n * 64;
#pragma unroll
        for (int ks = 0; ks < 2; ++ks) { const int ch = 32 * ks + 8 * g; float w[4][8], bb[8];
#pragma unroll
            for (int e = 0; e < 8; ++e) { bb[e] = cb[ch + e];
#pragma unroll
                for (int t = 0; t < 4; ++t) w[t][e] = cw[t * 512 + ch + e]; }
#pragma unroll
            for (int mq = 0; mq < (SPLIT ? 2 : 4); ++mq) { const int mt = SPLIT ? 2 * sub + mq : mq; float x[8];
#pragma unroll
                for (int e = 0; e < 8; ++e) x[e] = bb[e];
#pragma unroll
                for (int t = 0; t < 4; ++t) { const bf16x8 xv = *(const LAS bf16x8*)(xs + (16 * mt + c16 + t) * LSTR + ch);
#pragma unroll
                    for (int e = 0; e < 8; ++e) x[e] += w[t][e] * __uint_as_float((unsigned)(unsigned short)xv[e] << 16); }
                xcf[mq][ks].x = cvt_pk_bf16(x[0], x[1]); xcf[mq][ks].y = cvt_pk_bf16(x[2], x[3]); xcf[mq][ks].z = cvt_pk_bf16(x[4], x[5]); xcf[mq][ks].w = cvt_pk_bf16(x[6], x[7]); } }
        LDS_FENCE();
#pragma unroll
        for (int mq = 0; mq < (SPLIT ? 2 : 4); ++mq) { const int mt = SPLIT ? 2 * sub + mq : mq;
#pragma unroll
            for (int ks = 0; ks < 2; ++ks) *(LAS u32x4*)(xct + (16 * mt + c16) * LSTR + 32 * ks + 8 * g) = xcf[mq][ks]; }
        LDS_FENCE();
    }
    if (SPLIT) __syncthreads();
#define AFRAG(mt, ks) (*(const LAS bf16x8*)(xct + (16 * (c16 >> 2) + 4 * (mt) + (c16 & 3)) * LSTR + 32 * (ks) + 8 * g))
#pragma unroll
    for (int nq = 0; nq < (SPLIT ? 2 : 4); ++nq) { const int nt = 2 * hf + nq;
        float hs[4][4];
        const int ch = n * 64 + 16 * nt + c16;
        u32x4 yreg0 = (u32x4){0u, 0u, 0u, 0u}, yreg1 = yreg0;
        if (APPLY) { const bf16* yp = YB + ((size_t)row0 + lane) * 512 + n * 64 + 16 * nt; yreg0 = *(const u32x4*)yp; yreg1 = *(const u32x4*)(yp + 8); }
        float Hc[2] = {0.f, 0.f};
        if (APPLY) { Hc[0] = ((const float*)(ws + WS_CARRY))[(size_t)cgi * 512 + ch]; Hc[1] = ((const float*)(ws + WS_CARRY))[((size_t)576 + cgi) * 512 + ch]; }
#pragma unroll
        for (int dir = 0; dir < 2; ++dir) {
            const bf16* wr_ = WL + (size_t)(((layer * 2 + dir) * 2 + 0) * 8 + n) * 4096; const bf16* wi_ = wr_ + 8 * 4096;
            float2* AGG = (float2*)(ws + WS_AGG) + (size_t)dir * 576 * 512;
            const float br = P.in[18][(layer * 2 + dir) * 512 + ch], bi = P.in[20][(layer * 2 + dir) * 512 + ch], lam = P.in[16][(layer * 2 + dir) * 512 + ch];
            const float c8 = -8.0f * LOG2E * log1pf(expf(-lam));
            bf16x8 wrf[2], wif[2], idf;
#pragma unroll
            for (int ks = 0; ks < 2; ++ks) { wrf[ks] = *(const bf16x8*)(wr_ + (16 * nt + c16) * 64 + 32 * ks + 8 * g); wif[ks] = *(const bf16x8*)(wi_ + (16 * nt + c16) * 64 + 32 * ks + 8 * g); }
            { const int e = 16 * (nq & 1) + c16 - 8 * g;
#pragma unroll
              for (int q = 0; q < 8; ++q) idf[q] = (q == e) ? (short)0x3F80 : (short)0; }
            float av[4][4], bv[4][4];
#pragma unroll
            for (int mt = 0; mt < 4; ++mt) {
                f32x4 zr = (f32x4){0.f, 0.f, 0.f, 0.f}, zi = zr, xc = zr;
                const bf16x8 af0 = AFRAG(mt, 0), af1 = AFRAG(mt, 1);
                zr = MFMA16(af0, wrf[0], zr); zr = MFMA16(af1, wrf[1], zr);
                zi = MFMA16(af0, wif[0], zi); zi = MFMA16(af1, wif[1], zi);
                xc = MFMA16((SPLIT ? hf : (nq >> 1)) ? af1 : af0, idf, xc);
#pragma unroll
                for (int j = 0; j < 4; ++j) { const float rg = sigm(zr[j] + br), ig = sigm(zi[j] + bi); const float a = ex2(c8 * rg);
                    av[mt][j] = a; bv[mt][j] = sqrtf(fmaxf(1.0f - a * a, 0.f)) * ig * xc[j]; }
            }
            float H = APPLY ? Hc[dir] : 0.f;
            float Aloc = 1.f, Bloc = 0.f;
#pragma unroll
            for (int q = 0; q < 16; ++q) { const int s_ = dir == 0 ? q : 15 - q; const float a_ = av[s_ >> 2][s_ & 3], b_ = bv[s_ >> 2][s_ & 3]; Bloc = a_ * Bloc + b_; Aloc *= a_; }
            float Hin = H;
#pragma unroll
            for (int q = 0; q < 3; ++q) { const int gp = dir == 0 ? q : 3 - q; const float Ag = __shfl(Aloc, c16 + 16 * gp), Bg = __shfl(Bloc, c16 + 16 * gp); const float Hn = Ag * Hin + Bg;
                Hin = (dir == 0 ? g > gp : g < gp) ? Hn : Hin; }
            if (APPLY) { float h = Hin;
#pragma unroll
                for (int q = 0; q < 16; ++q) { const int s_ = dir == 0 ? q : 15 - q; h = av[s_ >> 2][s_ & 3] * h + bv[s_ >> 2][s_ & 3];
                    if (dir == 0) hs[s_ >> 2][s_ & 3] = h; else hs[s_ >> 2][s_ & 3] += h; } }
            H = __shfl(Aloc * Hin + Bloc, dir == 0 ? 48 + c16 : c16);
            float Aall = Aloc;
            if (!APPLY) { Aall *= __shfl_xor(Aall, 16); Aall *= __shfl_xor(Aall, 32); if (g == 0) AGG[(size_t)cgi * 512 + ch] = make_float2(Aall, H); }
            else if (ctx && g == 0 && ((dir == 0 && ci == nc - 1) || (dir == 1 && ci == 0))) P.out[OUT_ST + ((size_t)(b * 4 + layer) * 2 + dir) * 512 + ch] = H;
            PIN_MEM();
        }
        if (APPLY) {
            bf16* MIX = (bf16*)(ws + WS_MIX);
            LDS_FENCE();
            *(LAS u32x4*)(tsc + lane * 16) = yreg0; *(LAS u32x4*)(tsc + lane * 16 + 8) = yreg1;
            LDS_FENCE();
#pragma unroll
            for (int mt = 0; mt < 4; ++mt)
#pragma unroll
                for (int j = 0; j < 4; ++j) { LAS bf16* pe = tsc + (16 * g + 4 * mt + j) * 16 + c16;
                    const float y = __uint_as_float((unsigned)*pe << 16);
                    const float ge = y * sigm(1.5957691216057308f * (y + 0.044715f * y * y * y));
                    *pe = (bf16)(cvt_pk_bf16(hs[mt][j] * ge, 0.f) & 0xffffu); }
            LDS_FENCE();
            const u32x4 o0 = *(const LAS u32x4*)(tsc + lane * 16), o1 = *(const LAS u32x4*)(tsc + lane * 16 + 8);
            bf16* op = MIX + ((size_t)row0 + lane) * DM + 512 + n * 64 + 16 * nt; *(u32x4*)op = o0; *(u32x4*)(op + 8) = o1;
        }
        PIN_MEM();
    }
#undef AFRAG
}

__device__ __forceinline__ void carry_phase(int layer, const Params& P, unsigned char* ws, int gt, int ngt) {
    const float2* AGG = (const float2*)(ws + WS_AGG); float* CARRY = (float*)(ws + WS_CARRY);
    for (int it = gt; it < 24 * 2 * 512; it += ngt) {
        const int ch = it & 511, dir = (it >> 9) & 1, sq = it >> 10;
        const bool ctx = sq < 16; const int nc = ctx ? 4 : 64, cg0 = ctx ? sq * 4 : 64 + (sq - 16) * 64;
        float H = ctx ? 0.f : P.in[4][((size_t)((sq - 16) * 4 + layer) * 2 + dir) * 512 + ch];
        const float2* ag = AGG + ((size_t)dir * 576 + cg0) * 512 + ch; float* cr = CARRY + ((size_t)dir * 576 + cg0) * 512 + ch;
        if (ctx) { float2 ab[4];
#pragma unroll
            for (int k = 0; k < 4; ++k) { const int c = dir == 0 ? k : 3 - k; ab[k] = ag[(size_t)c * 512]; }
#pragma unroll
            for (int k = 0; k < 4; ++k) { const int c = dir == 0 ? k : 3 - k; cr[(size_t)c * 512] = H; H = ab[k].x * H + ab[k].y; }
        } else {
#pragma unroll 1
            for (int c0 = 0; c0 < 64; c0 += 16) { float2 ab[16];
#pragma unroll
                for (int k = 0; k < 16; ++k) { const int c = dir == 0 ? c0 + k : 63 - c0 - k; ab[k] = ag[(size_t)c * 512]; }
#pragma unroll
                for (int k = 0; k < 16; ++k) { const int c = dir == 0 ? c0 + k : 63 - c0 - k; cr[(size_t)c * 512] = H; H = ab[k].x * H + ab[k].y; } }
        }
    }
}

__device__ __forceinline__ void bias_layer(unsigned char* ws, int l, int lane, int widx, int nw) {
    const float* MODS = (const float*)(ws + WS_MODS); float* B1 = (float*)(ws + WS_BIAS1); float* B2 = (float*)(ws + WS_BIAS2);
    for (int rr = widx; rr < 8192; rr += nw) { const bool first = rr < 2560;
        const bf16* wrow = first ? (const bf16*)(ws + WS_WIN) + ((size_t)l * NIN + rr) * DM : (const bf16*)(ws + WS_WGU) + ((size_t)l * NGU + (rr - 2560)) * DM;
        const u32x4 wa = *(const u32x4*)(wrow + 16 * lane), wb = *(const u32x4*)(wrow + 16 * lane + 8); float wf[16];
#pragma unroll
        for (int e = 0; e < 4; ++e) { wf[2 * e] = __uint_as_float(wa[e] << 16); wf[2 * e + 1] = __uint_as_float(wa[e] & 0xffff0000u); wf[8 + 2 * e] = __uint_as_float(wb[e] << 16); wf[8 + 2 * e + 1] = __uint_as_float(wb[e] & 0xffff0000u); }
#pragma unroll 1
        for (int mg = 0; mg < 9; ++mg) { const float* sh = MODS + (size_t)(l * 9 + mg) * 6144 + (first ? 0 : 3072) + 16 * lane; float d = 0.f;
#pragma unroll
            for (int q = 0; q < 4; ++q) { const f32x4 sv = *(const f32x4*)(sh + 4 * q); d += (sv[0] * wf[4 * q] + sv[1] * wf[4 * q + 1]) + (sv[2] * wf[4 * q + 2] + sv[3] * wf[4 * q + 3]); }
            d = wave_sum(d);
            if (lane == 0) { if (first) B1[(size_t)(l * 9 + mg) * 2560 + rr] = d; else B2[(size_t)(l * 9 + mg) * 5632 + (rr - 2560)] = d; } }
    }
}
__device__ __forceinline__ void prep_phase(const Params& P, unsigned char* ws, int bid, int G, int tid, int wave, int lane) {
    const int gw = bid * 8 + wave, ngw = G * 8;
    const float* MODS = (const float*)(ws + WS_MODS); bf16* HN = (bf16*)(ws + WS_HN); float* PART = (float*)(ws + WS_PART);
    for (int row = gw; row < MTOK; row += ngw) {
        const float* xr = row < NCTX ? P.in[0] + (size_t)row * DM : P.in[1] + (size_t)(row - NCTX) * DM;
        const int mg = row < NCTX ? 0 : 1 + ((row - NCTX) >> 12); const float* mp = MODS + mg * 6144;
        float s = 0.f;
#pragma unroll
        for (int j = 0; j < 4; ++j) { const int c = 256 * j + 4 * lane; const f32x4 v = *(const f32x4*)(xr + c), w = *(const f32x4*)(P.in[9] + c), sc = *(const f32x4*)(mp + 1024 + c);
            s += (v[0] * v[0] + v[1] * v[1]) + (v[2] * v[2] + v[3] * v[3]);
            const f32x4 o = v * (w * (sc + 1.0f)); u32x2 pk; pk.x = cvt_pk_bf16(o[0], o[1]); pk.y = cvt_pk_bf16(o[2], o[3]); *(u32x2*)(HN + (size_t)row * DM + c) = pk; }
        s = wave_sum(s);
        if (lane < 4) PART[(size_t)row * 4 + lane] = lane == 0 ? s : 0.f;
    }
    {
        float* WP = (float*)(ws + WS_WP);
        for (int i = bid * 512 + tid; i < 4 * 2 * 9 * 1024; i += G * 512) { const int c = i & 1023, t = i >> 10, mg = t % 9, lw = t / 9, which = lw & 1, l = lw >> 1;
            WP[i] = P.in[which ? 10 : 9][l * 1024 + c] * (1.0f + MODS[(size_t)(l * 9 + mg) * 6144 + (which ? 4096 : 1024) + c]); }
    }
    bias_layer(ws, 0, lane, gw, ngw);
}

__global__ void __launch_bounds__(512, 2) hybrid_fwd(Params P) {
    extern __shared__ __attribute__((aligned(16))) unsigned char lds_raw[];
    LAS unsigned char* lds = (LAS unsigned char*)lds_raw;
    cg::grid_group grid = cg::this_grid();
    int ph = 0;
#ifndef REP
#define REP 0u
#endif
#define REPEAT(k) for (int rep_ = 0; rep_ < (int)((REP >> (k)) & 1u) + 1; ++rep_)
#define IDS int tid = threadIdx.x; asm volatile("" : "+v"(tid)); int bid = IDS_BID; asm volatile("" : "+s"(bid)); int G = gridDim.x; asm volatile("" : "+s"(G)); \
    const int lane = tid & 63, wave = __builtin_amdgcn_readfirstlane(tid >> 6), gw = bid * 8 + wave, ngw = G * 8; \
    size_t zoff = 0; asm volatile("" : "+s"(zoff)); unsigned char* ws = P.ws + zoff; float* XR = P.out + zoff; (void)lane; (void)gw; (void)ngw; (void)ws; (void)XR;
#define PHASE_BEGIN if (ph >= P.ph_lo && ph < P.ph_hi) {
#define PHASE_END   if (ph + 1 < P.ph_hi) { xcd_barrier(xbar); if ((REP >> 12) & 1u) xcd_barrier(xbar); } } ++ph;
    volatile LAS unsigned* bst = (volatile LAS unsigned*)(lds + LDS_BYTES - 64);
    if (threadIdx.x < 3) bst[threadIdx.x] = 0u;
    XcdBarrier xbar;
#define IDS_BID blockIdx.x
    { IDS if (ph >= P.ph_lo && ph < P.ph_hi) { if (bid == 0) for (int i = tid; i < XCD_BAR_WORDS; i += 512) ((unsigned*)ws)[i] = 0u;
        REPEAT(0) { prologue(P, lds, tid, wave, lane); __syncthreads(); }
        if (ph + 1 < P.ph_hi) grid.sync(); } ++ph;
      xbar = xcd_barrier_post((unsigned*)ws, bst); }
    { IDS PHASE_BEGIN prep_phase(P, ws, bid, G, tid, wave, lane); PHASE_END }
#undef IDS_BID
#define IDS_BID vbid
    int vbid = blockIdx.x;
    if (P.ph_hi > 2) { const unsigned* bw = (const unsigned*)P.ws; bool okc = (gridDim.x & 7) == 0;
        for (int j = 0; j < 16; ++j) { const unsigned c = xb_ld((unsigned*)bw + XB_XCNT(j)); okc = okc && (j < 8 ? c == gridDim.x / 8 : c == 0u); }
        __syncthreads();
        vbid = __builtin_amdgcn_readfirstlane(okc ? (int)(bst[2] * 8u + xbar.x) : (int)blockIdx.x); }
#pragma unroll 1
    for (int l = 0; l < DEPTH; ++l) {
        IDS
        bf16 *HN = (bf16*)(ws + WS_HN), *MIX = (bf16*)(ws + WS_MIX), *ACT = (bf16*)(ws + WS_ACT);
        const float* mods = (const float*)(ws + WS_MODS) + (size_t)l * 9 * 6144;
        const float* xlo = l == 0 ? P.in[0] : XR; const float* xhi = l == 0 ? P.in[1] : XR + (size_t)NCTX * DM;
        PHASE_BEGIN {
            pg8::Gemm gm{HN, (const bf16*)(ws + WS_WIN) + (size_t)l * NIN * DM, MTOK, NIN, DM}; pg8::RstdOrder S; S.init(MTOK, NIN, G, bid); S.PART = (const float*)(ws + WS_PART); S.sbuf = (LAS float*)(lds + 131072); S.cnt = 0; S.bias = (const float*)(ws + WS_BIAS1) + (size_t)l * 9 * 2560; S.bstride = 2560;
            pg8::EpiIn E{ws, XR, l, (LAS float*)(lds + 131072), 0};
            REPEAT(2) pg8::gemm_phase<pg8::EpiIn, pg8::RstdOrder, true, true>(lds, gm, S, E); } PHASE_END
        PHASE_BEGIN {
            LAS float* rpbs = (LAS float*)(lds + wave * 3840);
#define LOAD_RPB(hh) do { LDS_FENCE(); for (int i = lane; i < 15 * 64; i += 64) { const int ri = i >> 6, cpos = (i & 63) - 16; \
                rpbs[i] = (cpos >= 0 && cpos < 31) ? P.in[13][((size_t)(l * 8 + (hh)) * 15 + ri) * 31 + cpos] * LOG2E : 0.f; } LDS_FENCE(); } while (0)
            REPEAT(3) { if (G == 256) {
                    const int bx = bid & 7, bc = bid >> 3; LAS unsigned char* stg = lds + 32768;
                    for (int hp = 0; hp < 4; ++hp) { const int h = 2 * hp + (bc >> 4), r0 = 4 * (bc & 15); LOAD_RPB(h);
                        if (wave & 1) attn_wg_half<1>(true, bx, h, r0, l, ws, rpbs, stg, tid, wave, lane); else attn_wg_half<0>(true, bx, h, r0, l, ws, rpbs, stg, tid, wave, lane); }
                    if (bc < 16) { const int cb_ = 2 * bx + (bc >> 3), h = bc & 7;
                        if (wave & 1) attn_wg_half<1>(false, cb_, h, 0, l, ws, rpbs, stg, tid, wave, lane); else attn_wg_half<0>(false, cb_, h, 0, l, ws, rpbs, stg, tid, wave, lane); }
                    __syncthreads();
                } else { LOAD_RPB(wave); for (int u = gw; u < 4608; u += ngw) attn_unit(u, l, ws, rpbs, lane); } }
#undef LOAD_RPB
            REPEAT(4) for (int u = (ngw - 1 - gw); u < 9216; u += ngw) lru_unit<false>(u, l, P, lds + 32768 + (wave >> 1) * 9728, lds + 32768 + 4 * 9728 + (wave >> 1) * 9216, (LAS bf16*)(lds + wave * 3840), lane);
        } PHASE_END
        PHASE_BEGIN carry_phase(l, P, ws, bid * 512 + tid, G * 512); PHASE_END
        PHASE_BEGIN { REPEAT(5) for (int u = gw; u < 9216; u += ngw) lru_unit<true>(u, l, P, lds + 32768 + (wave >> 1) * 9728, lds + 32768 + 4 * 9728 + (wave >> 1) * 9216, (LAS bf16*)(lds + wave * 3840), lane); } PHASE_END
        PHASE_BEGIN {
            pg8::Gemm gm{MIX, (const bf16*)(ws + WS_WOUT) + (size_t)l * DM * DM, MTOK, DM, DM}; pg8::StaticOrder S; S.init(MTOK, DM, G, bid);
            pg8::EpiRes E{l == 0 ? P.in[0] : (const float*)nullptr, l == 0 ? P.in[1] : (const float*)nullptr, XR, l * 9 * 6144 + 2048, ws, l * 2 + 1, (LAS float*)(lds + 131072)};
            pg8::gemm_phase<pg8::EpiRes, pg8::StaticOrder, true, true>(lds, gm, S, E);
            if (l < DEPTH - 1) { const bool idle = (G == 256); if (!idle || bid >= 64) convert_layer(P, ws, l + 1, (LAS float*)(lds + wave * 8448), lane, idle ? (bid - 64) * 8 + wave : gw, idle ? 192 * 8 : ngw); } } PHASE_END
        PHASE_BEGIN {
            pg8::Gemm gm{HN, (const bf16*)(ws + WS_WGU) + (size_t)l * NGU * DM, MTOK, NGU, DM}; pg8::RstdOrder S; S.init(MTOK, NGU, G, bid); S.PART = (const float*)(ws + WS_PART); S.sbuf = (LAS float*)(lds + 131072); S.cnt = 0; S.bias = (const float*)(ws + WS_BIAS2) + (size_t)l * 9 * 5632; S.bstride = 5632;
            pg8::EpiGU E{ACT, (LAS float*)(lds + 131072), 0};
            REPEAT(8) pg8::gemm_phase<pg8::EpiGU, pg8::RstdOrder, true, true>(lds, gm, S, E); } PHASE_END
        PHASE_BEGIN {
            pg8::Gemm gm{ACT, (const bf16*)(ws + WS_WDN) + (size_t)l * DM * DFF, MTOK, DM, DFF}; pg8::StaticOrder S; S.init(MTOK, DM, G, bid);
            pg8::EpiRes E{(const float*)nullptr, (const float*)nullptr, XR, l * 9 * 6144 + 5120, ws, l < DEPTH - 1 ? (l + 1) * 2 : -1, (LAS float*)(lds + 131072)};
            pg8::gemm_phase<pg8::EpiRes, pg8::StaticOrder, true, true>(lds, gm, S, E);
            if (l < DEPTH - 1) { const bool idle = (G == 256); if (!idle || bid >= 64) bias_layer(ws, l + 1, lane, idle ? (bid - 64) * 8 + wave : gw, idle ? 192 * 8 : ngw); } } PHASE_END
    }
    { IDS PHASE_BEGIN final_norm_phase(XR, P.in[24], gw, ngw, lane); PHASE_END }
}

#ifndef N_LAUNCH_MODE
#define N_LAUNCH_MODE 1
#endif
extern "C" void kernel_launch(void* const* d_in, const int* in_sizes, int n_in, void* d_out, int out_size, void* d_ws, size_t ws_size, hipStream_t stream) {
    static int grid = 0;
    if (grid == 0) {
        int dev = 0, cus = 0, per_cu = 0;
        hipGetDevice(&dev); hipDeviceGetAttribute(&cus, hipDeviceAttributeMultiprocessorCount, dev);
        if (hipFuncSetAttribute((const void*)hybrid_fwd, hipFuncAttributeMaxDynamicSharedMemorySize, LDS_BYTES) != hipSuccess) fprintf(stderr, "kernel_launch: hipFuncSetAttribute failed\n");
        if (hipOccupancyMaxActiveBlocksPerMultiprocessor(&per_cu, (const void*)hybrid_fwd, 512, LDS_BYTES) != hipSuccess || per_cu < 1) { fprintf(stderr, "kernel_launch: occupancy query says %d\n", per_cu); per_cu = 1; }
        (void)hipGetLastError();
        grid = cus * 1;
        if (n_in != 25 || ws_size < 444 * MiB) fprintf(stderr, "kernel_launch: unexpected n_in %d / ws %zu\n", n_in, ws_size);
    }
    Params p{};
    for (int i = 0; i < 25; ++i) p.in[i] = (const float*)d_in[i];
    p.out = (float*)d_out; p.ws = (unsigned char*)d_ws;
#if N_LAUNCH_MODE == 1
    p.ph_lo = 0; p.ph_hi = 31;
    void* args[] = {&p};
    hipError_t e = hipLaunchCooperativeKernel((const void*)hybrid_fwd, dim3(grid), dim3(512), args, LDS_BYTES, stream);
    if (e != hipSuccess) fprintf(stderr, "cooperative launch failed: %s (grid %d)\n", hipGetErrorString(e), grid);
#else
    for (int ph = 0; ph < 31; ++ph) { p.ph_lo = ph; p.ph_hi = ph + 1; hipLaunchKernelGGL(hybrid_fwd, dim3(grid), dim3(512), LDS_BYTES, stream, p); }
#endif
}
```
